# Optimizing an MI355X kernel written in HIP

```python
import jax, jax.numpy as jnp
from jax import lax
import numpy as np

D_MODEL = 1024
BATCH = 2
SEQ = 8192
DEPTH = 4

GRID_W = 64
CTX_LEN = 256
EXPAND = 2
D_INNER = EXPAND * D_MODEL
RWKV_WIDTH = D_INNER // 2
RWKV_HEAD = 64
RWKV_HEADS = RWKV_WIDTH // RWKV_HEAD
RWKV_W_LORA = 64
RWKV_A_LORA = 64
RWKV_GN_EPS = 64e-5
SHIFT_WIDTH = 3 * RWKV_WIDTH + 2 * RWKV_W_LORA + 2 * RWKV_A_LORA
HGRN_WIDTH = D_INNER // 2
HGRN_HEAD = 128
HGRN_HEADS = HGRN_WIDTH // HGRN_HEAD
HGRN_CHUNK = 64
EVEN_IN = SHIFT_WIDTH + 4 * HGRN_WIDTH + D_INNER
DIFF_HEAD = 64
DIFF_HEADS = D_INNER // (2 * DIFF_HEAD)
ODD_IN = 4 * D_INNER
Q_BLOCK = 128
ROPE_BASE = 10000.0
N_EVEN = (DEPTH + 1) // 2
N_ODD = DEPTH // 2
DEEPNORM_ALPHA = (2.0 * DEPTH) ** 0.25
DEEPNORM_BETA = (8.0 * DEPTH) ** -0.25
LN_EPS = 1e-5

kernel_name = 'hybrid_rwkv7_hgrn2_diffattn_deepnorm_prefix'


def _split(z, sizes):
    idx = [int(i) for i in np.cumsum(sizes)[:-1]]
    return jnp.split(z, idx, axis=-1)


def _layer_norm(x, g, b):
    xf = x.astype(jnp.float32)
    mu = jnp.mean(xf, -1, keepdims=True)
    var = jnp.mean(jnp.square(xf - mu), -1, keepdims=True)
    return ((xf - mu) * lax.rsqrt(var + LN_EPS)).astype(x.dtype) * g + b


def _head_norm(y, g, b, eps):
    yf = y.astype(jnp.float32)
    mu = jnp.mean(yf, -1, keepdims=True)
    var = jnp.mean(jnp.square(yf - mu), -1, keepdims=True)
    return ((yf - mu) * lax.rsqrt(var + eps)).astype(y.dtype) * g + b


def _rms_norm(y, g):
    yf = y.astype(jnp.float32)
    return (yf * lax.rsqrt(jnp.mean(jnp.square(yf), -1, keepdims=True) + LN_EPS)).astype(y.dtype) * g


def _centred_shift(p, mu_prev, mu_next):
    zero = jnp.zeros_like(p[:, :1])
    prev = jnp.concatenate([zero, p[:, :-1]], 1)
    nxt = jnp.concatenate([p[:, 1:], zero], 1)
    return p + mu_prev * (prev - p) + mu_next * (nxt - p)


def _rwkv7_inputs(ps, w0, w2, a0, a2, k_k, k_a):
    b, t, _ = ps.shape
    r, k, v, wlo, alo = _split(ps, [RWKV_WIDTH] * 3 + [2 * RWKV_W_LORA, 2 * RWKV_A_LORA])
    wlo = wlo.reshape(b, t, 2, RWKV_W_LORA)
    alo = alo.reshape(b, t, 2, RWKV_A_LORA)
    w_log = -jax.nn.softplus(-(w0 + jnp.einsum('btdr,drc->btdc', jnp.tanh(wlo), w2))) - 0.5
    decay = jnp.exp(-jnp.exp(w_log))
    a = jax.nn.sigmoid(a0 + jnp.einsum('btdr,drc->btdc', alo, a2))
    k_dir = k[:, :, None] * (1 + (a - 1) * k_a)
    heads = lambda u: u.reshape(u.shape[:-1] + (RWKV_HEADS, RWKV_HEAD))
    kk = heads(k * k_k).astype(jnp.float32)
    kk = (kk * lax.rsqrt(jnp.sum(jnp.square(kk), -1, keepdims=True) + 1e-12)).astype(ps.dtype)
    return heads(r), heads(k), heads(v), kk, heads(decay), heads(a), heads(k_dir)


def _rwkv7_scan(s0, inputs, d, reverse):
    r, _, v, kk, decay, a, k_dir = inputs

    def step(s, inp):
        r_t, w_t, k_t, v_t, kk_t, a_t = inp
        s = (s * w_t[:, :, None, :]
             - jnp.einsum('bhvk,bhk->bhv', s, kk_t)[..., None] * (kk_t * a_t)[:, :, None, :]
             + v_t[..., None] * k_t[:, :, None, :])
        return s, jnp.einsum('bhvk,bhk->bhv', s, r_t)

    xs = tuple(jnp.moveaxis(z, 1, 0) for z in (r, decay[:, :, d], k_dir[:, :, d], v, kk, a[:, :, d]))
    s, y = lax.scan(step, s0, xs, reverse=reverse)
    return s, jnp.moveaxis(y, 0, 1)


def _rwkv7_readout(y, inputs, r_k, g, b):
    r, k, v = inputs[:3]
    shp = (RWKV_HEADS, RWKV_HEAD)
    yn = _head_norm(y, g.reshape(shp), b.reshape(shp), RWKV_GN_EPS)
    bonus = jnp.sum(r * k * r_k.reshape(shp), -1, keepdims=True) * v
    return (yn + bonus).reshape(y.shape[:2] + (RWKV_WIDTH,))


def _rwkv7_branch(p, pc, mu_prev, mu_next, w0, w2, a0, a2, k_k, k_a, r_k, lnx_g, lnx_b, need_ctx):
    lat = _rwkv7_inputs(_centred_shift(p, mu_prev, mu_next), w0, w2, a0, a2, k_k, k_a)
    cx = _rwkv7_inputs(_centred_shift(pc, mu_prev, mu_next), w0, w2, a0, a2, k_k, k_a)
    s0 = jnp.zeros((p.shape[0], RWKV_HEADS, RWKV_HEAD, RWKV_HEAD), p.dtype)
    y = 0.0
    yc = 0.0
    for d, rev in enumerate((False, True)):
        s_ctx, yc_d = _rwkv7_scan(s0, cx, d, rev)
        _, y_d = _rwkv7_scan(s_ctx, lat, d, rev)
        y = y + y_d
        yc = yc + yc_d
    out = _rwkv7_readout(y, lat, r_k, lnx_g, lnx_b)
    out_c = _rwkv7_readout(yc, cx, r_k, lnx_g, lnx_b) if need_ctx else None
    return out, out_c


def _hgrn2_gates(z, lb_d):
    k = (1 - lb_d) * jax.nn.sigmoid(-z)
    log_f = jnp.log1p(-k)
    return log_f, k


def _hgrn2_scan(s0, q, log_f, k, v, reverse):
    if reverse:
        q, log_f, k, v = (jnp.flip(z, 1) for z in (q, log_f, k, v))
    b, t, h, _ = q.shape
    n = t // HGRN_CHUNK
    to_chunks = lambda z: z.reshape(b, n, HGRN_CHUNK, h, -1).transpose(1, 0, 3, 2, 4)
    mask = jnp.tril(jnp.ones((HGRN_CHUNK, HGRN_CHUNK), bool))[:, :, None]

    def step(s, inp):
        q_c, g_c, k_c, v_c = inp
        cum = jnp.cumsum(g_c, axis=2)
        diff = cum[:, :, :, None, :] - cum[:, :, None, :, :]
        dec = jnp.where(mask, jnp.exp(jnp.where(mask, diff, 0.0)), 0.0)
        scores = jnp.einsum('bhtsk,bhsk->bhts', q_c[:, :, :, None, :] * dec, k_c)
        o = (jnp.einsum('bhts,bhsv->bhtv', scores, v_c)
             + jnp.einsum('bhtk,bhkv->bhtv', q_c * jnp.exp(cum), s))
        last = cum[:, :, -1:, :]
        s = jnp.exp(last[:, :, 0])[..., None] * s + jnp.einsum('bhsk,bhsv->bhkv', k_c * jnp.exp(last - cum), v_c)
        return s, o

    s, o = lax.scan(step, s0, tuple(to_chunks(z) for z in (q, log_f, k, v)))
    o = o.transpose(1, 0, 3, 2, 4).reshape(b, t, h, -1)
    if reverse:
        o = jnp.flip(o, 1)
    return s, o


def _hgrn2_branch(p, pc, lb, norm_g, need_ctx):
    def prep(z):
        b, t, _ = z.shape
        heads = lambda u: u.reshape(b, t, HGRN_HEADS, HGRN_HEAD)
        q, f_fwd, f_bwd, i = jnp.split(z, 4, axis=-1)
        gates = [tuple(heads(u) for u in _hgrn2_gates(f, lb[d])) for d, f in enumerate((f_fwd, f_bwd))]
        return heads(jax.nn.silu(q)), gates, heads(i)

    q, g, i = prep(p)
    qc, gc, ic = prep(pc)
    s0 = jnp.zeros((p.shape[0], HGRN_HEADS, HGRN_HEAD, HGRN_HEAD), p.dtype)
    o = 0.0
    oc = 0.0
    for d, rev in enumerate((False, True)):
        s_ctx, oc_d = _hgrn2_scan(s0, qc, gc[d][0], gc[d][1], ic, rev)
        _, o_d = _hgrn2_scan(s_ctx, q, g[d][0], g[d][1], i, rev)
        o = o + o_d
        oc = oc + oc_d
    y = _rms_norm(o, norm_g).reshape(p.shape[:2] + (HGRN_WIDTH,))
    yc = _rms_norm(oc, norm_g).reshape(pc.shape[:2] + (HGRN_WIDTH,)) if need_ctx else None
    return y, yc


def _even_mixer(h, hc, w_in, mu_prev, mu_next, w0, w2, a0, a2, k_k, k_a, r_k, lnx_g, lnx_b, lb, norm_g, need_ctx):
    p = h @ w_in
    pc = hc @ (w_in if need_ctx else w_in[:, :EVEN_IN - D_INNER])
    hs = SHIFT_WIDTH
    he = SHIFT_WIDTH + 4 * HGRN_WIDTH
    ya, yac = _rwkv7_branch(p[..., :hs], pc[..., :hs], mu_prev, mu_next, w0, w2, a0, a2,
                            k_k, k_a, r_k, lnx_g, lnx_b, need_ctx)
    yb, ybc = _hgrn2_branch(p[..., hs:he], pc[..., hs:he], lb, norm_g, need_ctx)
    y = jnp.concatenate([ya, yb], -1) * jax.nn.silu(p[..., he:])
    yc = jnp.concatenate([yac, ybc], -1) * jax.nn.silu(pc[..., he:]) if need_ctx else None
    return y, yc


def _rope_2d(x, rows, cols):
    half = x.shape[-1] // 2
    quarter = half // 2
    inv = ROPE_BASE ** (-jnp.arange(quarter, dtype=jnp.float32) / quarter)

    def rot(xa, pos):
        ang = pos.astype(jnp.float32)[:, None] * inv
        cos = jnp.cos(ang)[None, :, None, None, :].astype(x.dtype)
        sin = jnp.sin(ang)[None, :, None, None, :].astype(x.dtype)
        x1, x2 = xa[..., :quarter], xa[..., quarter:]
        return jnp.concatenate([x1 * cos - x2 * sin, x1 * sin + x2 * cos], -1)

    return jnp.concatenate([rot(x[..., :half], rows), rot(x[..., half:], cols)], -1)


def _diff_attend(q, k, v, lam):
    s = jnp.einsum('bhmqd,bhmkd->bhmqk', q, k).astype(jnp.float32) * (DIFF_HEAD ** -0.5)
    p = jax.nn.softmax(s, axis=-1)
    attn = (p[:, :, 0] - lam * p[:, :, 1]).astype(v.dtype)
    return jnp.einsum('bhqk,bhkv->bhqv', attn, v)


def _odd_mixer(h, hc, w_in, lam_p, subln_g, lam_init, rows, cols, need_ctx):
    b, t, _ = h.shape
    q, k, v, g = jnp.split(h @ w_in, 4, axis=-1)
    if need_ctx:
        qc, kc, vc, gc = jnp.split(hc @ w_in, 4, axis=-1)
    else:
        kc, vc = jnp.split(hc @ w_in[:, D_INNER:3 * D_INNER], 2, axis=-1)
    qk_heads = lambda u: u.reshape(u.shape[0], u.shape[1], DIFF_HEADS, 2, DIFF_HEAD)
    v_heads = lambda u: u.reshape(u.shape[0], u.shape[1], DIFF_HEADS, 2 * DIFF_HEAD)
    to_bhm = lambda u: u.transpose(0, 2, 3, 1, 4)
    q = _rope_2d(qk_heads(q), rows, cols)
    k = _rope_2d(qk_heads(k), rows, cols)
    kc = qk_heads(kc)
    vc = v_heads(vc)
    lam = jnp.exp(jnp.sum(lam_p[0] * lam_p[1])) - jnp.exp(jnp.sum(lam_p[2] * lam_p[3])) + lam_init
    k_all = to_bhm(jnp.concatenate([kc, k], 1))
    v_all = jnp.concatenate([vc, v_heads(v)], 1).transpose(0, 2, 1, 3)
    n_blk = t // Q_BLOCK
    q_blocks = q.reshape(b, n_blk, Q_BLOCK, DIFF_HEADS, 2, DIFF_HEAD).transpose(1, 0, 3, 4, 2, 5)
    o = lax.map(lambda qb: _diff_attend(qb, k_all, v_all, lam), q_blocks)
    o = o.transpose(1, 0, 3, 2, 4).reshape(b, t, DIFF_HEADS, 2 * DIFF_HEAD)
    y = (_rms_norm(o, subln_g) * (1 - lam_init)).reshape(b, t, D_INNER) * jax.nn.silu(g)
    if need_ctx:
        oc = _diff_attend(to_bhm(qk_heads(qc)), to_bhm(kc), vc.transpose(0, 2, 1, 3), lam).transpose(0, 2, 1, 3)
        yc = (_rms_norm(oc, subln_g) * (1 - lam_init)).reshape(b, -1, D_INNER) * jax.nn.silu(gc)
    else:
        yc = None
    return y, yc


def setup_inputs(seed: int = 0) -> dict:
    key = jax.random.key(seed)
    ks = iter(jax.random.split(key, 32))

    def nrm(shape, std):
        return std * jax.random.normal(next(ks), shape, jnp.float32)

    def unif(shape, lo, hi):
        return jax.random.uniform(next(ks), shape, jnp.float32, lo, hi)

    d, di = D_MODEL, D_INNER
    ramp = jnp.linspace(-6.0, 1.0, RWKV_WIDTH, dtype=jnp.float32)
    return {
        'x': nrm((BATCH, SEQ, d), 1.0),
        'c': nrm((BATCH, d), 1.0),
        'ctx': nrm((BATCH, CTX_LEN, d), 1.0),
        'c_ctx': nrm((d,), 1.0),
        'ada_w': nrm((DEPTH, d, 3 * d), 0.5 * d ** -0.5),
        'ada_b': nrm((DEPTH, 3 * d), 0.02),
        'ln_g': 1.0 + nrm((DEPTH, d), 0.02),
        'ln_b': nrm((DEPTH, d), 0.02),
        'even_w_in': nrm((N_EVEN, d, EVEN_IN), d ** -0.5),
        'even_w_out': nrm((N_EVEN, di, d), DEEPNORM_BETA * di ** -0.5),
        'rwkv_mu_prev': unif((N_EVEN, SHIFT_WIDTH), 0.1, 0.45),
        'rwkv_mu_next': unif((N_EVEN, SHIFT_WIDTH), 0.1, 0.45),
        'rwkv_w0': ramp + nrm((N_EVEN, 2, RWKV_WIDTH), 0.1),
        'rwkv_w2': nrm((N_EVEN, 2, RWKV_W_LORA, RWKV_WIDTH), 0.1),
        'rwkv_a0': nrm((N_EVEN, 2, RWKV_WIDTH), 0.1),
        'rwkv_a2': nrm((N_EVEN, 2, RWKV_A_LORA, RWKV_WIDTH), 0.1),
        'rwkv_k_k': 0.85 + nrm((N_EVEN, RWKV_WIDTH), 0.02),
        'rwkv_k_a': 1.0 + nrm((N_EVEN, RWKV_WIDTH), 0.02),
        'rwkv_r_k': nrm((N_EVEN, RWKV_WIDTH), 0.1),
        'rwkv_lnx_g': 1.0 + nrm((N_EVEN, RWKV_WIDTH), 0.02),
        'rwkv_lnx_b': nrm((N_EVEN, RWKV_WIDTH), 0.02),
        'hgrn_lb_logits': nrm((N_EVEN, 2, HGRN_WIDTH), 0.5),
        'hgrn_norm_g': 1.0 + nrm((N_EVEN, HGRN_HEAD), 0.02),
        'odd_w_in': nrm((N_ODD, d, ODD_IN), d ** -0.5),
        'odd_w_out': nrm((N_ODD, di, d), DEEPNORM_BETA * di ** -0.5),
        'diff_lambda': nrm((N_ODD, 4, DIFF_HEAD), 0.1),
        'diff_subln_g': 1.0 + nrm((N_ODD, 2 * DIFF_HEAD), 0.02),
    }


def reference(x, c, ctx, c_ctx, ada_w, ada_b, ln_g, ln_b, even_w_in, even_w_out,
              rwkv_mu_prev, rwkv_mu_next, rwkv_w0, rwkv_w2, rwkv_a0, rwkv_a2,
              rwkv_k_k, rwkv_k_a, rwkv_r_k, rwkv_lnx_g, rwkv_lnx_b,
              hgrn_lb_logits, hgrn_norm_g, odd_w_in, odd_w_out, diff_lambda, diff_subln_g):
    n_tok = x.shape[1]
    n_rows = n_tok // GRID_W
    rows = jnp.repeat(jnp.arange(n_rows), GRID_W)
    cols = jnp.tile(jnp.arange(GRID_W), n_rows)
    lb_all = jax.nn.softmax(hgrn_lb_logits.astype(jnp.float32), axis=0)
    lb_all = (jnp.cumsum(lb_all, axis=0) - lb_all[0]).astype(x.dtype)
    cond = jax.nn.silu(c)
    cond_ctx = jax.nn.silu(c_ctx)
    for layer in range(DEPTH):
        need_ctx = layer < DEPTH - 1
        shift, scale, gate = jnp.split(cond @ ada_w[layer] + ada_b[layer], 3, axis=-1)
        shift_c, scale_c, gate_c = jnp.split(cond_ctx @ ada_w[layer] + ada_b[layer], 3, axis=-1)
        h = x * (1 + scale[:, None]) + shift[:, None]
        hc = ctx * (1 + scale_c) + shift_c
        j = layer // 2
        if layer % 2 == 0:
            y, yc = _even_mixer(h, hc, even_w_in[j], rwkv_mu_prev[j], rwkv_mu_next[j], rwkv_w0[j], rwkv_w2[j],
                                rwkv_a0[j], rwkv_a2[j], rwkv_k_k[j], rwkv_k_a[j], rwkv_r_k[j],
                                rwkv_lnx_g[j], rwkv_lnx_b[j], lb_all[j], hgrn_norm_g[j], need_ctx)
            w_out = even_w_out[j]
        else:
            lam_init = 0.8 - 0.6 * float(np.exp(-0.3 * layer))
            y, yc = _odd_mixer(h, hc, odd_w_in[j], diff_lambda[j], diff_subln_g[j], lam_init, rows, cols, need_ctx)
            w_out = odd_w_out[j]
        x = _layer_norm(DEEPNORM_ALPHA * x + gate[:, None] * (y @ w_out), ln_g[layer], ln_b[layer])
        if need_ctx:
            ctx = _layer_norm(DEEPNORM_ALPHA * ctx + gate_c * (yc @ w_out), ln_g[layer], ln_b[layer])
    return x
```

```cpp
#include <hip/hip_runtime.h>
#include <hip/hip_cooperative_groups.h>
#include <cstdio>
#include <cmath>
namespace cg = cooperative_groups;

#define DI __device__ __forceinline__
typedef unsigned short bf16_t;
typedef __attribute__((ext_vector_type(8))) short bf16x8;
typedef __attribute__((ext_vector_type(4))) short s16x4;
typedef __attribute__((ext_vector_type(16))) float f32x16;
typedef __attribute__((ext_vector_type(4))) float f32x4;
typedef __attribute__((ext_vector_type(4))) unsigned u32x4;
typedef __attribute__((ext_vector_type(2))) unsigned u32x2;
typedef __attribute__((ext_vector_type(2))) float f32x2;
typedef __attribute__((ext_vector_type(2))) __bf16 bf16x2v;
#define MFMA32(a, b, c) __builtin_amdgcn_mfma_f32_32x32x16_bf16((a), (b), (c), 0, 0, 0)

constexpr int NR = 16896, NLAT = 16384;
constexpr int NTHR = 512;
constexpr float ALPHA = 1.681792830507429f;

constexpr size_t SZ_WT   = 23592960;
constexpr size_t OFF_WT  = 0;
constexpr size_t OFF_HB  = OFF_WT + SZ_WT;
constexpr size_t OFF_YAB = OFF_HB + (size_t)NR * 1024 * 2;
constexpr size_t OFF_XCTX = OFF_YAB + (size_t)NR * 2048 * 2;
constexpr size_t OFF_MOD = OFF_XCTX + 512 * 1024 * 4;
constexpr size_t OFF_LB  = OFF_MOD + 4 * 3 * 3072 * 4;
constexpr size_t OFF_ROPE = OFF_LB + 2 * 2 * 1024 * 4;
constexpr size_t OFF_LAM = OFF_ROPE + 128 * 16 * 2 * 4;
constexpr size_t OFF_BIG = OFF_LAM + 256;
constexpr size_t SZ_PRWKV = (size_t)NR * 3328 * 2;
constexpr size_t SZ_HG = (size_t)NR * 4096 * 2;
constexpr size_t SZ_N2048 = (size_t)NR * 2048 * 2;
constexpr size_t WS_NEEDED = OFF_BIG + SZ_HG + (size_t)NR * 1024 * 2;

struct Params {
  const float *x, *c, *ctx, *c_ctx, *ada_w, *ada_b, *ln_g, *ln_b, *even_w_in, *even_w_out;
  const float *mu_prev, *mu_next, *w0, *w2, *a0, *a2, *k_k, *k_a, *r_k, *lnx_g, *lnx_b, *lb_logits, *hnorm_g;
  const float *odd_w_in, *odd_w_out, *diff_lambda, *subln_g;
  float* out;
  char* ws;
  float lam_init[2];
};

DI unsigned pack2(float a, float b) { f32x2 v = {a, b}; bf16x2v r = __builtin_convertvector(v, bf16x2v); return __builtin_bit_cast(unsigned, r); }
DI bf16_t f2bf(float x) { return (bf16_t)(pack2(x, 0.f) & 0xffffu); }
DI float bf2f(bf16_t h) { return __uint_as_float(((unsigned)h) << 16); }
DI float bflo(unsigned u) { return __uint_as_float(u << 16); }
DI float bfhi(unsigned u) { return __uint_as_float(u & 0xffff0000u); }
DI int crow(int reg, int h) { return (reg & 3) + 8 * (reg >> 2) + 4 * h; }
DI int opaque_tid() { int t = threadIdx.x; asm volatile("" : "+v"(t)); return t; }
DI float sigmoidf_(float z) { return 1.f / (1.f + __expf(-z)); }
DI float siluf_(float z) { return z / (1.f + __expf(-z)); }

template <int CTRL> DI float dpp_mov(float x) {
  return __int_as_float(__builtin_amdgcn_update_dpp(0, __float_as_int(x), CTRL, 0xf, 0xf, true));
}
DI float red16(float x) {
  x += dpp_mov<0xB1>(x); x += dpp_mov<0x4E>(x); x += dpp_mov<0x141>(x); x += dpp_mov<0x140>(x); return x;
}
DI float red8(float x) {
  x += dpp_mov<0xB1>(x); x += dpp_mov<0x4E>(x); x += dpp_mov<0x141>(x); return x;
}
DI float wave_sum(float x) {
  for (int o = 32; o > 0; o >>= 1) x += __shfl_xor(x, o);
  return x;
}

DI void unpack8(u32x4 u, float* o) {
  o[0] = bflo(u.x); o[1] = bfhi(u.x); o[2] = bflo(u.y); o[3] = bfhi(u.y);
  o[4] = bflo(u.z); o[5] = bfhi(u.z); o[6] = bflo(u.w); o[7] = bfhi(u.w);
}
DI u32x4 pack8(const float* v) { u32x4 r; r.x = pack2(v[0], v[1]); r.y = pack2(v[2], v[3]); r.z = pack2(v[4], v[5]); r.w = pack2(v[6], v[7]); return r; }

DI void load_shift8(const bf16_t* __restrict__ p, int row, bool hasprev, bool hasnext, int col,
                    const float* __restrict__ mup, const float* __restrict__ mun, float* o) {
  const u32x4 z4 = {0u, 0u, 0u, 0u};
  u32x4 cu = *(const u32x4*)(p + (size_t)row * 3328 + col);
  u32x4 pv = hasprev ? *(const u32x4*)(p + (size_t)(row - 1) * 3328 + col) : z4;
  u32x4 nx = hasnext ? *(const u32x4*)(p + (size_t)(row + 1) * 3328 + col) : z4;
  float4 mp0 = *(const float4*)(mup + col), mp1 = *(const float4*)(mup + col + 4);
  float4 mn0 = *(const float4*)(mun + col), mn1 = *(const float4*)(mun + col + 4);
  float c[8], a[8], b[8];
  unpack8(cu, c); unpack8(pv, a); unpack8(nx, b);
  float mp[8] = {mp0.x, mp0.y, mp0.z, mp0.w, mp1.x, mp1.y, mp1.z, mp1.w};
  float mn[8] = {mn0.x, mn0.y, mn0.z, mn0.w, mn1.x, mn1.y, mn1.z, mn1.w};
#pragma unroll
  for (int e = 0; e < 8; ++e) o[e] = c[e] + mp[e] * (a[e] - c[e]) + mn[e] * (b[e] - c[e]);
}

DI void row_seg(int row, int& pos, int& seglen) {
  if (row < NLAT) { pos = row & 8191; seglen = 8192; } else { pos = (row - NLAT) & 255; seglen = 256; }
}
DI int chunk_row(int c, int i, int d, int b) {
  int seglen, segbase, cc;
  if (c < 8) { seglen = 256; segbase = NLAT + b * 256; cc = c; } else { seglen = 8192; segbase = b * 8192; cc = c - 8; }
  int pos = cc * 32 + i;
  if (d) pos = seglen - 1 - pos;
  return segbase + pos;
}

DI void convert_wt(const float* __restrict__ W, int K, int N, bf16_t* __restrict__ Wt, char* smem) {
  float(*tile)[65] = (float(*)[65])smem;
  const int tid = opaque_tid();
  const int tilesK = K / 64, tilesN = N / 64;
  for (int t = blockIdx.x; t < tilesK * tilesN; t += gridDim.x) {
    int tk = t % tilesK, tn = t / tilesK;
    __syncthreads();
    {
      int kr = tid >> 4, nc = (tid & 15) * 4;
#pragma unroll
      for (int i = 0; i < 2; ++i) {
        float4 v = *(const float4*)(W + (size_t)(tk * 64 + kr + 32 * i) * N + tn * 64 + nc);
        tile[kr + 32 * i][nc + 0] = v.x; tile[kr + 32 * i][nc + 1] = v.y; tile[kr + 32 * i][nc + 2] = v.z; tile[kr + 32 * i][nc + 3] = v.w;
      }
    }
    __syncthreads();
    {
      int n = tid >> 3, kc = (tid & 7) * 8;
      float v[8];
#pragma unroll
      for (int e = 0; e < 8; ++e) v[e] = tile[kc + e][n];
      *(u32x4*)(Wt + (size_t)(tn * 64 + n) * K + tk * 64 + kc) = pack8(v);
    }
  }
}

DI void convert_layer_weights(const Params& P, int layer, char* smem) {
  bf16_t* wt = (bf16_t*)(P.ws + OFF_WT);
  int j = layer >> 1;
  if ((layer & 1) == 0) {
    convert_wt(P.even_w_in + (size_t)j * 1024 * 9472, 1024, 9472, wt, smem);
    convert_wt(P.even_w_out + (size_t)j * 2048 * 1024, 2048, 1024, wt + (size_t)9472 * 1024, smem);
  } else {
    convert_wt(P.odd_w_in + (size_t)j * 1024 * 8192, 1024, 8192, wt, smem);
    convert_wt(P.odd_w_out + (size_t)j * 2048 * 1024, 2048, 1024, wt + (size_t)8192 * 1024, smem);
  }
}

DI void prologue_phase(const Params& P, char* smem) {
  const int tid = opaque_tid();
  float* mod = (float*)(P.ws + OFF_MOD);
  {
    float* sc = (float*)smem;
    float* red = sc + 3072;
    for (int task = blockIdx.x; task < 192; task += gridDim.x) {
      int layer = task / 48, cgp = task % 48;
      __syncthreads();
      for (int i = tid; i < 3072; i += NTHR) {
        int rc = i >> 10, k = i & 1023;
        float cv = rc < 2 ? P.c[rc * 1024 + k] : P.c_ctx[k];
        sc[i] = siluf_(cv);
      }
      __syncthreads();
      int col = cgp * 64 + (tid & 63), kg = tid >> 6;
      float a0 = 0.f, a1 = 0.f, a2 = 0.f;
      const float* wp = P.ada_w + ((size_t)layer * 1024 + kg * 128) * 3072 + col;
#pragma unroll 8
      for (int k = 0; k < 128; ++k) {
        float w = wp[(size_t)k * 3072];
        a0 += sc[kg * 128 + k] * w; a1 += sc[1024 + kg * 128 + k] * w; a2 += sc[2048 + kg * 128 + k] * w;
      }
      red[(kg * 3 + 0) * 64 + (tid & 63)] = a0; red[(kg * 3 + 1) * 64 + (tid & 63)] = a1; red[(kg * 3 + 2) * 64 + (tid & 63)] = a2;
      __syncthreads();
      if (tid < 192) {
        int rc = tid >> 6, l = tid & 63;
        float s = 0.f;
        for (int g = 0; g < 8; ++g) s += red[(g * 3 + rc) * 64 + l];
        int cc = cgp * 64 + l;
        mod[((size_t)layer * 3 + rc) * 3072 + cc] = s + P.ada_b[layer * 3072 + cc];
      }
    }
  }
  const int gtid = blockIdx.x * NTHR + tid, gstride = gridDim.x * NTHR;
  {
    float* lb = (float*)(P.ws + OFF_LB);
    for (int i = gtid; i < 2048; i += gstride) {
      float l0 = P.lb_logits[i], l1 = P.lb_logits[2048 + i];
      lb[i] = 0.f; lb[2048 + i] = 1.f / (1.f + expf(l0 - l1));
    }
  }
  {
    float* rope = (float*)(P.ws + OFF_ROPE);
    for (int i = gtid; i < 2048; i += gstride) {
      int pos = i >> 4, jj = i & 15;
      float inv = powf(10000.f, -(float)jj / 16.f);
      float ang = (float)pos * inv;
      rope[2 * i] = cosf(ang); rope[2 * i + 1] = sinf(ang);
    }
  }
  if (blockIdx.x == 0 && tid < 128) {
    int j = tid >> 6, l = tid & 63;
    const float* lp = P.diff_lambda + j * 256;
    float s01 = wave_sum(lp[l] * lp[64 + l]);
    float s23 = wave_sum(lp[128 + l] * lp[192 + l]);
    if (l == 0) ((float*)(P.ws + OFF_LAM))[j] = expf(s01) - expf(s23) + P.lam_init[j];
  }
  {
    const float4* xs = (const float4*)P.x; float4* xd = (float4*)P.out;
    for (int i = gtid; i < NLAT * 256; i += gstride) xd[i] = xs[i];
    const float4* cs = (const float4*)P.ctx; float4* cd = (float4*)(P.ws + OFF_XCTX);
    for (int i = gtid; i < 512 * 256; i += gstride) cd[i] = cs[i];
  }
  convert_layer_weights(P, 0, smem);
}

DI void ln_phase(const Params& P, int layer, bool do_ln, bool write_hb, int next_layer) {
  const int tid = opaque_tid(), wave = tid >> 6, lane = tid & 63;
  const float* mod = (const float*)(P.ws + OFF_MOD);
  bf16_t* hb = (bf16_t*)(P.ws + OFF_HB);
  float* xctx = (float*)(P.ws + OFF_XCTX);
  for (int row = blockIdx.x * 8 + wave; row < NR; row += gridDim.x * 8) {
    float* xp = row < NLAT ? P.out + (size_t)row * 1024 : xctx + (size_t)(row - NLAT) * 1024;
    float4 v[4];
#pragma unroll
    for (int i = 0; i < 4; ++i) v[i] = ((float4*)xp)[lane + 64 * i];
    if (do_ln) {
      float s = 0.f;
#pragma unroll
      for (int i = 0; i < 4; ++i) s += v[i].x + v[i].y + v[i].z + v[i].w;
      float mu = wave_sum(s) * (1.f / 1024.f);
      float q = 0.f;
#pragma unroll
      for (int i = 0; i < 4; ++i) {
        float a = v[i].x - mu, b = v[i].y - mu, c = v[i].z - mu, d = v[i].w - mu;
        q += a * a + b * b + c * c + d * d;
      }
      float rs = rsqrtf(wave_sum(q) * (1.f / 1024.f) + 1e-5f);
#pragma unroll
      for (int i = 0; i < 4; ++i) {
        float4 g = ((const float4*)(P.ln_g + layer * 1024))[lane + 64 * i];
        float4 b = ((const float4*)(P.ln_b + layer * 1024))[lane + 64 * i];
        v[i].x = (v[i].x - mu) * rs * g.x + b.x; v[i].y = (v[i].y - mu) * rs * g.y + b.y;
        v[i].z = (v[i].z - mu) * rs * g.z + b.z; v[i].w = (v[i].w - mu) * rs * g.w + b.w;
        ((float4*)xp)[lane + 64 * i] = v[i];
      }
    }
    if (write_hb) {
      int rc = row < NLAT ? (row >> 13) : 2;
      const float* mp = mod + ((size_t)next_layer * 3 + rc) * 3072;
#pragma unroll
      for (int i = 0; i < 4; ++i) {
        float4 sh = ((const float4*)mp)[lane + 64 * i];
        float4 sc = ((const float4*)(mp + 1024))[lane + 64 * i];
        uint2 o;
        o.x = pack2(v[i].x * (1.f + sc.x) + sh.x, v[i].y * (1.f + sc.y) + sh.y);
        o.y = pack2(v[i].z * (1.f + sc.z) + sh.z, v[i].w * (1.f + sc.w) + sh.w);
        *(uint2*)(hb + (size_t)row * 1024 + (lane + 64 * i) * 4) = o;
      }
    }
  }
}

enum { EPI_R = 0, EPI_H = 1, EPI_G = 2, EPI_O = 3, EPI_QK = 4, EPI_V = 5 };

template <int EPI>
DI void gemm_phase(const Params& P, const bf16_t* __restrict__ A, int lda, const bf16_t* __restrict__ Bt,
                   int Nt, int K, int layer, char* smem, int Mt = NR / 256) {
  bf16_t(*sA)[256][72] = (bf16_t(*)[256][72])smem;
  bf16_t(*sB)[256][72] = (bf16_t(*)[256][72])(smem + 2 * 256 * 72 * 2);
  const int tid = opaque_tid(), wave = tid >> 6, lane = tid & 63, r = lane & 31, h = lane >> 5;
  const int wm = wave >> 2, wn = wave & 3;
  const int j = layer >> 1;
  const int nk = K / 64;
  const int T = Mt * Nt;
  const bool swz = (gridDim.x == 256);
  for (int base = 0; base < T; base += gridDim.x) {
    const int v = base + (swz ? ((blockIdx.x & 7) * 32 + (blockIdx.x >> 3)) : blockIdx.x);
    if (v >= T) break;
    const int grp = v / (Mt * 4);
    const int nw = min(4, Nt - grp * 4);
    const int w = v - grp * Mt * 4;
    const int tm = w / nw, tn = grp * 4 + (w - tm * nw);
    const int m0 = tm * 256, n0 = tn * 256;
    constexpr bool swap = (EPI == EPI_V);
    f32x16 acc[4][2];
#pragma unroll
    for (int mi = 0; mi < 4; ++mi)
#pragma unroll
      for (int ni = 0; ni < 2; ++ni)
#pragma unroll
        for (int i = 0; i < 16; ++i) acc[mi][ni][i] = 0.f;
    const char* Au = (const char*)(A + (size_t)m0 * lda);
    const char* Bu = (const char*)(Bt + (size_t)n0 * K);
    const unsigned aoff = ((unsigned)(tid >> 3) * (unsigned)lda + (unsigned)(tid & 7) * 8u) * 2u;
    const unsigned boff = ((unsigned)(tid >> 3) * (unsigned)K + (unsigned)(tid & 7) * 8u) * 2u;
    u32x4 ra[4], rb[4];
#pragma unroll
    for (int i = 0; i < 4; ++i) {
      ra[i] = *(const u32x4*)(Au + (size_t)i * 128 * lda + aoff);
      rb[i] = *(const u32x4*)(Bu + (size_t)i * 128 * K + boff);
    }
    __syncthreads();
#pragma unroll
    for (int i = 0; i < 4; ++i) {
      *(u32x4*)&sA[0][(tid >> 3) + 64 * i][(tid & 7) * 8] = ra[i];
      *(u32x4*)&sB[0][(tid >> 3) + 64 * i][(tid & 7) * 8] = rb[i];
    }
    __syncthreads();
    for (int kt = 0; kt < nk; ++kt) {
      const int cb = kt & 1;
      if (kt + 1 < nk) {
#pragma unroll
        for (int i = 0; i < 4; ++i) {
          ra[i] = *(const u32x4*)(Au + ((size_t)i * 128 * lda + (kt + 1) * 128) + aoff);
          rb[i] = *(const u32x4*)(Bu + ((size_t)i * 128 * K + (kt + 1) * 128) + boff);
        }
      }
      __builtin_amdgcn_sched_barrier(0);
      {
        bf16x8 af[2][4], bfr[2][2];
#pragma unroll
        for (int mi = 0; mi < 4; ++mi) af[0][mi] = *(const bf16x8*)&sA[cb][wm * 128 + mi * 32 + r][8 * h];
#pragma unroll
        for (int ni = 0; ni < 2; ++ni) bfr[0][ni] = *(const bf16x8*)&sB[cb][wn * 64 + ni * 32 + r][8 * h];
#pragma unroll
        for (int s = 0; s < 4; ++s) {
          const int cs = s & 1, ns = cs ^ 1;
          if (s < 3) {
#pragma unroll
            for (int mi = 0; mi < 4; ++mi) af[ns][mi] = *(const bf16x8*)&sA[cb][wm * 128 + mi * 32 + r][16 * (s + 1) + 8 * h];
#pragma unroll
            for (int ni = 0; ni < 2; ++ni) bfr[ns][ni] = *(const bf16x8*)&sB[cb][wn * 64 + ni * 32 + r][16 * (s + 1) + 8 * h];
          }
          if (swap) {
#pragma unroll
            for (int mi = 0; mi < 4; ++mi)
#pragma unroll
              for (int ni = 0; ni < 2; ++ni) acc[mi][ni] = MFMA32(bfr[cs][ni], af[cs][mi], acc[mi][ni]);
          } else {
#pragma unroll
            for (int mi = 0; mi < 4; ++mi)
#pragma unroll
              for (int ni = 0; ni < 2; ++ni) acc[mi][ni] = MFMA32(af[cs][mi], bfr[cs][ni], acc[mi][ni]);
          }
        }
      }
      if (kt + 1 < nk) {
#pragma unroll
        for (int i = 0; i < 4; ++i) {
          *(u32x4*)&sA[cb ^ 1][(tid >> 3) + 64 * i][(tid & 7) * 8] = ra[i];
          *(u32x4*)&sB[cb ^ 1][(tid >> 3) + 64 * i][(tid & 7) * 8] = rb[i];
        }
      }
      __syncthreads();
    }
    if (EPI == EPI_R) {
      bf16_t* dst = (bf16_t*)(P.ws + OFF_BIG);
#pragma unroll
      for (int mi = 0; mi < 4; ++mi)
#pragma unroll
        for (int ni = 0; ni < 2; ++ni)
#pragma unroll
          for (int i = 0; i < 16; ++i) {
            int row = m0 + wm * 128 + mi * 32 + crow(i, h), col = n0 + wn * 64 + ni * 32 + r;
            dst[(size_t)row * 3328 + col] = f2bf(acc[mi][ni][i]);
          }
    } else if (EPI == EPI_H) {
      bf16_t* dst = (bf16_t*)(P.ws + OFF_BIG);
      const float* lb = (const float*)(P.ws + OFF_LB);
      const int region = n0 >> 10;
#pragma unroll
      for (int mi = 0; mi < 4; ++mi)
#pragma unroll
        for (int ni = 0; ni < 2; ++ni) {
          int col = n0 + wn * 64 + ni * 32 + r;
          float lbv = (region == 1 || region == 2) ? lb[(j * 2 + (region - 1)) * 1024 + (col & 1023)] : 0.f;
#pragma unroll
          for (int i = 0; i < 16; ++i) {
            int row = m0 + wm * 128 + mi * 32 + crow(i, h);
            float v = acc[mi][ni][i], o;
            if (region == 0) o = siluf_(v);
            else if (region == 3) o = v;
            else o = (1.f - lbv) * sigmoidf_(-v);
            dst[(size_t)row * 4096 + col] = f2bf(o);
          }
        }
    } else if (EPI == EPI_G) {
      bf16_t* yab = (bf16_t*)(P.ws + OFF_YAB);
#pragma unroll
      for (int mi = 0; mi < 4; ++mi)
#pragma unroll
        for (int ni = 0; ni < 2; ++ni)
#pragma unroll
          for (int i = 0; i < 16; ++i) {
            int row = m0 + wm * 128 + mi * 32 + crow(i, h), col = n0 + wn * 64 + ni * 32 + r;
            size_t idx = (size_t)row * 2048 + col;
            yab[idx] = f2bf(bf2f(yab[idx]) * siluf_(acc[mi][ni][i]));
          }
    } else if (EPI == EPI_O) {
      const float* mod = (const float*)(P.ws + OFF_MOD);
      const int rc = m0 < NLAT ? (m0 >> 13) : 2;
      float* xbase = m0 < NLAT ? P.out : ((float*)(P.ws + OFF_XCTX)) - (size_t)NLAT * 1024;
#pragma unroll
      for (int mi = 0; mi < 4; ++mi)
#pragma unroll
        for (int ni = 0; ni < 2; ++ni) {
          int col = n0 + wn * 64 + ni * 32 + r;
          float gate = mod[((size_t)layer * 3 + rc) * 3072 + 2048 + col];
#pragma unroll
          for (int i = 0; i < 16; ++i) {
            int row = m0 + wm * 128 + mi * 32 + crow(i, h);
            float* xp = xbase + (size_t)row * 1024 + col;
            *xp = ALPHA * (*xp) + gate * acc[mi][ni][i];
          }
        }
    } else {
      if (EPI == EPI_QK) {
        const float* rope = (const float*)(P.ws + OFF_ROPE);
        bf16_t* dst = n0 < 2048 ? (bf16_t*)(P.ws + OFF_YAB) : (bf16_t*)(P.ws + OFF_BIG);
        const int cofs = n0 < 2048 ? 0 : 2048;
        const bool lat = m0 < NLAT;
#pragma unroll
        for (int mi = 0; mi < 4; ++mi)
#pragma unroll
          for (int ni = 0; ni < 2; ++ni) {
            int col = n0 + wn * 64 + ni * 32 + r;
#pragma unroll
            for (int i = 0; i < 16; ++i) {
              int row = m0 + wm * 128 + mi * 32 + crow(i, h);
              float v = acc[mi][ni][i];
              float pr = __shfl_xor(v, 16);
              float o = v;
              if (lat) {
                int t = row & 8191;
                int pos = (ni == 0) ? (t >> 6) : (t & 63);
                float2 cs = *(const float2*)(rope + (pos * 16 + (r & 15)) * 2);
                o = (r & 16) ? (pr * cs.y + v * cs.x) : (v * cs.x - pr * cs.y);
              }
              dst[(size_t)row * 2048 + (col - cofs)] = f2bf(o);
            }
          }
      } else {
        const int bb = m0 < NLAT ? (m0 >> 13) : ((m0 - NLAT) >> 8);
        const int key0 = m0 < NLAT ? 256 + (m0 & 8191) : ((m0 - NLAT) & 255);
        char* vtu = (char*)((bf16_t*)(P.ws + OFF_BIG + SZ_N2048) + ((size_t)(bb * 2048 + n0) * 8448 + key0));
#pragma unroll
        for (int mi = 0; mi < 4; ++mi) {
          const unsigned lane_off = ((unsigned)(wn * 64 + 4 * h) * 8448u + (unsigned)(wm * 128 + mi * 32 + r)) * 2u;
#pragma unroll
          for (int ni = 0; ni < 2; ++ni)
#pragma unroll
            for (int i = 0; i < 16; ++i) {
              const size_t eo = (size_t)(ni * 32 + (i & 3) + 8 * (i >> 2)) * 8448u * 2u;
              *(bf16_t*)((vtu + eo) + (size_t)lane_off) = f2bf(acc[mi][ni][i]);
            }
        }
      }
    }
  }
}

DI void rwkv_scan_phase(const Params& P, int j, char* smem) {
  typedef float (*arr64)[32][64];
  arr64 sw = (arr64)smem;
  arr64 skk = (arr64)(smem + 16384);
  arr64 skka = (arr64)(smem + 2 * 16384);
  arr64 skd = (arr64)(smem + 3 * 16384);
  arr64 srr = (arr64)(smem + 4 * 16384);
  float(*svv)[32][16] = (float(*)[32][16])(smem + 5 * 16384);
  float(*syb)[32][16] = (float(*)[32][16])(smem + 5 * 16384 + 4096);
  float(*stk)[64] = (float(*)[64])(smem + 5 * 16384 + 8192);
  bf16_t(*twl)[72] = (bf16_t(*)[72])(smem + 5 * 16384 + 16384);
  bf16_t(*tal)[72] = (bf16_t(*)[72])(smem + 5 * 16384 + 16384 + 4608);

  const int tid = opaque_tid(), wave = tid >> 6, lane = tid & 63;
  const bool is_scan = wave < 4;
  const bf16_t* prw = (const bf16_t*)(P.ws + OFF_BIG);
  const float* mup = P.mu_prev + j * 3328;
  const float* mun = P.mu_next + j * 3328;
  constexpr int NCH = 264;

  for (int item = blockIdx.x; item < 256; item += gridDim.x) {
    const int rg = item & 3, d = (item >> 2) & 1, hh = (item >> 3) & 15, b = item >> 7;
    const int rl = (wave & 3) * 4 + ((lane >> 4) & 3), cgl = lane & 15;
    f32x4 S = {0.f, 0.f, 0.f, 0.f};
    const int ptid = tid - 256, pti = (ptid >> 3) & 31, cgp = ptid & 7;
    const int pw = (wave - 4) & 3, r = lane & 31, h = lane >> 5;
    bf16x8 bfr[4];
    float c0 = 0.f, c1 = 0.f;
    if (!is_scan) {
      const float* W2 = (pw < 2 ? P.w2 : P.a2) + (size_t)(j * 2 + d) * 64 * 1024;
      const int hcol = hh * 64 + (pw & 1) * 32 + r;
#pragma unroll
      for (int s = 0; s < 4; ++s)
#pragma unroll
        for (int e = 0; e < 8; ++e) bfr[s][e] = (short)f2bf(W2[(size_t)(16 * s + 8 * h + e) * 1024 + hcol]);
      c0 = (pw < 2 ? P.w0 : P.a0)[(j * 2 + d) * 1024 + hcol];
      c1 = P.k_a[j * 1024 + hcol];
    }
    bf16_t* ydst = d == 0 ? (bf16_t*)(P.ws + OFF_YAB) : (bf16_t*)(P.ws + OFF_BIG + SZ_PRWKV);
    const int yld = d == 0 ? 2048 : 1024;

    const int gcol[5] = {hh * 64 + cgp * 8, 1024 + hh * 64 + cgp * 8, 2048 + hh * 64 + cgp * 8, 3072 + d * 64 + cgp * 8, 3200 + d * 64 + cgp * 8};
    f32x4 kkv[2];
    u32x4 raw[5][3];
    float(*smu)[2][64] = (float(*)[2][64])(smem + 107520);
    if (!is_scan) {
      kkv[0] = *(const f32x4*)(P.k_k + j * 1024 + hh * 64 + cgp * 8); kkv[1] = *(const f32x4*)(P.k_k + j * 1024 + hh * 64 + cgp * 8 + 4);
    }
    auto issue = [&](int c) {
      int row = chunk_row(c, pti, d, b);
      int pos, seglen; row_seg(row, pos, seglen);
      bool hp = pos > 0, hn = pos < seglen - 1;
      const u32x4 z4 = {0u, 0u, 0u, 0u};
      const bf16_t* base = prw + (size_t)row * 3328;
#pragma unroll
      for (int g = 0; g < 5; ++g) {
        raw[g][0] = *(const u32x4*)(base + gcol[g]);
        raw[g][1] = hp ? *(const u32x4*)(base - 3328 + gcol[g]) : z4;
        raw[g][2] = hn ? *(const u32x4*)(base + 3328 + gcol[g]) : z4;
      }
    };
    auto shifted = [&](int g, float* o) {
      float cc[8], aa[8], bb[8];
      unpack8(raw[g][0], cc); unpack8(raw[g][1], aa); unpack8(raw[g][2], bb);
#pragma unroll
      for (int e = 0; e < 8; ++e) {
        float mp = smu[g][0][cgp * 8 + e], mn = smu[g][1][cgp * 8 + e];
        o[e] = cc[e] + mp * (aa[e] - cc[e]) + mn * (bb[e] - cc[e]);
      }
    };
    auto prep1 = [&](int c) {
      const int buf = c & 1;
      float v[8];
      shifted(0, v);
      *(f32x4*)&srr[buf][pti][cgp * 8] = (f32x4){v[0], v[1], v[2], v[3]};
      *(f32x4*)&srr[buf][pti][cgp * 8 + 4] = (f32x4){v[4], v[5], v[6], v[7]};
      shifted(1, v);
      *(f32x4*)&stk[pti][cgp * 8] = (f32x4){v[0], v[1], v[2], v[3]};
      *(f32x4*)&stk[pti][cgp * 8 + 4] = (f32x4){v[4], v[5], v[6], v[7]};
      {
        float kr[8] = {v[0] * kkv[0].x, v[1] * kkv[0].y, v[2] * kkv[0].z, v[3] * kkv[0].w, v[4] * kkv[1].x, v[5] * kkv[1].y, v[6] * kkv[1].z, v[7] * kkv[1].w};
        float ss = 0.f;
#pragma unroll
        for (int e = 0; e < 8; ++e) ss += kr[e] * kr[e];
        ss = red8(ss);
        float rn = rsqrtf(ss + 1e-12f);
        *(f32x4*)&skk[buf][pti][cgp * 8] = (f32x4){kr[0] * rn, kr[1] * rn, kr[2] * rn, kr[3] * rn};
        *(f32x4*)&skk[buf][pti][cgp * 8 + 4] = (f32x4){kr[4] * rn, kr[5] * rn, kr[6] * rn, kr[7] * rn};
      }
      shifted(2, v);
      if ((cgp >> 1) == rg) {
        *(f32x4*)&svv[buf][pti][(cgp & 1) * 8] = (f32x4){v[0], v[1], v[2], v[3]};
        *(f32x4*)&svv[buf][pti][(cgp & 1) * 8 + 4] = (f32x4){v[4], v[5], v[6], v[7]};
      }
      shifted(3, v);
#pragma unroll
      for (int e = 0; e < 8; ++e) v[e] = 1.f - 2.f / (1.f + __expf(2.f * v[e]));
      *(u32x4*)&twl[pti][cgp * 8] = pack8(v);
      shifted(4, v);
      *(u32x4*)&tal[pti][cgp * 8] = pack8(v);
    };
    auto prep2 = [&](int c) {
      const int buf = c & 1;
      bf16_t(*tA)[72] = pw < 2 ? twl : tal;
      f32x16 acc;
#pragma unroll
      for (int i = 0; i < 16; ++i) acc[i] = 0.f;
#pragma unroll
      for (int s = 0; s < 4; ++s) {
        bf16x8 a = *(const bf16x8*)&tA[r][16 * s + 8 * h];
        acc = MFMA32(a, bfr[s], acc);
      }
      const int col = (pw & 1) * 32 + r;
      if (pw < 2) {
#pragma unroll
        for (int i = 0; i < 16; ++i) {
          int tok = crow(i, h);
          float sg = sigmoidf_(c0 + acc[i]);
          sw[buf][tok][col] = __expf(-0.6065306597f * sg);
        }
      } else {
#pragma unroll
        for (int i = 0; i < 16; ++i) {
          int tok = crow(i, h);
          float a = sigmoidf_(c0 + acc[i]);
          float kv = stk[tok][col], kkv = skk[buf][tok][col];
          skd[buf][tok][col] = kv * (1.f + (a - 1.f) * c1);
          skka[buf][tok][col] = kkv * a;
        }
      }
    };
    auto scan_steps = [&](int c, int t0) {
      const int buf = c & 1;
      float ykeep = 0.f;
#pragma unroll
      for (int tt = 0; tt < 16; ++tt) {
        const int t = t0 + tt;
        f32x4 w4 = *(const f32x4*)&sw[buf][t][cgl * 4];
        f32x4 k4 = *(const f32x4*)&skk[buf][t][cgl * 4];
        f32x4 ka4 = *(const f32x4*)&skka[buf][t][cgl * 4];
        f32x4 kd4 = *(const f32x4*)&skd[buf][t][cgl * 4];
        f32x4 r4 = *(const f32x4*)&srr[buf][t][cgl * 4];
        float vv = svv[buf][t][rl];
        float dp = (S.x * k4.x + S.y * k4.y) + (S.z * k4.z + S.w * k4.w);
        dp = red16(dp);
        f32x4 u = kd4 * vv - ka4 * dp;
        S = S * w4 + u;
        float y = (S.x * r4.x + S.y * r4.y) + (S.z * r4.z + S.w * r4.w);
        y = red16(y);
        ykeep = (cgl == tt) ? y : ykeep;
      }
      syb[buf][t0 + cgl][rl] = ykeep;
    };
    auto flush = [&](int c) {
      const int buf = c & 1;
      int ti = tid >> 3, pr = tid & 7;
      int row = chunk_row(c, ti, d, b);
      unsigned o = pack2(syb[buf][ti][2 * pr], syb[buf][ti][2 * pr + 1]);
      *(unsigned*)(ydst + (size_t)row * yld + hh * 64 + rg * 16 + 2 * pr) = o;
    };

    __syncthreads();
    if (!is_scan) {
      issue(0);
      for (int i = ptid; i < 640; i += 256) {
        int g = i >> 7, pn = (i >> 6) & 1, cc = i & 63;
        int gb = g == 0 ? hh * 64 : g == 1 ? 1024 + hh * 64 : g == 2 ? 2048 + hh * 64 : g == 3 ? 3072 + d * 64 : 3200 + d * 64;
        smu[g][pn][cc] = (pn ? mun : mup)[gb + cc];
      }
    }
    __syncthreads();
    if (!is_scan) { prep1(0); issue(1); }
    __syncthreads();
    if (!is_scan) prep2(0);
    __syncthreads();
    for (int c = 0; c < NCH; ++c) {
      if (is_scan) { if (c > 0) flush(c - 1); scan_steps(c, 0); }
      else if (c + 1 < NCH) { prep1(c + 1); issue(min(c + 2, NCH - 1)); }
      __syncthreads();
      if (is_scan) scan_steps(c, 16);
      else if (c + 1 < NCH) prep2(c + 1);
      __syncthreads();
    }
    if (is_scan) flush(NCH - 1);
  }
}

DI void rwkv_readout_phase(const Params& P, int j) {
  const bf16_t* prw = (const bf16_t*)(P.ws + OFF_BIG);
  const bf16_t* ybw = (const bf16_t*)(P.ws + OFF_BIG + SZ_PRWKV);
  bf16_t* yab = (bf16_t*)(P.ws + OFF_YAB);
  const float* mup = P.mu_prev + j * 3328;
  const float* mun = P.mu_next + j * 3328;
  const int total = NR * 128;
  for (int task = blockIdx.x * NTHR + opaque_tid(); task < total; task += gridDim.x * NTHR) {
    int row = task >> 7, hc = task & 127;
    int col = hc * 8;
    int pos, seglen; row_seg(row, pos, seglen);
    bool hp = pos > 0, hn = pos < seglen - 1;
    float yf[8], yb[8], y[8];
    unpack8(*(const u32x4*)(yab + (size_t)row * 2048 + col), yf);
    unpack8(*(const u32x4*)(ybw + (size_t)row * 1024 + col), yb);
    float s = 0.f;
#pragma unroll
    for (int e = 0; e < 8; ++e) { y[e] = yf[e] + yb[e]; s += y[e]; }
    float mu = red8(s) * (1.f / 64.f);
    float q = 0.f;
#pragma unroll
    for (int e = 0; e < 8; ++e) { float dlt = y[e] - mu; q += dlt * dlt; }
    float rs = rsqrtf(red8(q) * (1.f / 64.f) + 64e-5f);
    float rr[8], kk[8], vv[8];
    load_shift8(prw, row, hp, hn, col, mup, mun, rr);
    load_shift8(prw, row, hp, hn, 1024 + col, mup, mun, kk);
    load_shift8(prw, row, hp, hn, 2048 + col, mup, mun, vv);
    float bsum = 0.f;
#pragma unroll
    for (int e = 0; e < 8; ++e) bsum += rr[e] * kk[e] * P.r_k[j * 1024 + col + e];
    bsum = red8(bsum);
    float o[8];
#pragma unroll
    for (int e = 0; e < 8; ++e)
      o[e] = (y[e] - mu) * rs * P.lnx_g[j * 1024 + col + e] + P.lnx_b[j * 1024 + col + e] + bsum * vv[e];
    *(u32x4*)(yab + (size_t)row * 2048 + col) = pack8(o);
  }
}

DI void hgrn_scan_phase(const Params& P, int j, char* smem) {
  typedef float (*arr128)[32][128];
  arr128 sq = (arr128)smem;
  arr128 sk = (arr128)(smem + 32768);
  float(*svv)[32][16] = (float(*)[32][16])(smem + 65536);
  float(*syb)[32][16] = (float(*)[32][16])(smem + 65536 + 4096);
  const int tid = opaque_tid(), wave = tid >> 6, lane = tid & 63;
  const bool is_scan = wave < 4;
  const bf16_t* hg = (const bf16_t*)(P.ws + OFF_BIG);
  constexpr int NCH = 264;
  for (int item = blockIdx.x; item < 256; item += gridDim.x) {
    const int vg = item & 7, d = (item >> 3) & 1, hh = (item >> 4) & 7, b = item >> 7;
    const int rl = (wave & 3) * 4 + ((lane >> 4) & 3), kg = lane & 15;
    const int ptid = tid - 256, pti = (ptid >> 3) & 31, cgp = ptid & 7;
    float S[8];
#pragma unroll
    for (int e = 0; e < 8; ++e) S[e] = 0.f;
    bf16_t* ydst = d == 0 ? (bf16_t*)(P.ws + OFF_YAB) + 1024 : (bf16_t*)(P.ws + OFF_BIG + SZ_HG);
    const int yld = d == 0 ? 2048 : 1024;

    u32x4 hraw[5];
    auto issue = [&](int c) {
      int row = chunk_row(c, pti, d, b);
      const bf16_t* hr = hg + (size_t)row * 4096;
      hraw[0] = *(const u32x4*)(hr + hh * 128 + cgp * 16);
      hraw[1] = *(const u32x4*)(hr + hh * 128 + cgp * 16 + 8);
      hraw[2] = *(const u32x4*)(hr + 1024 * (1 + d) + hh * 128 + cgp * 16);
      hraw[3] = *(const u32x4*)(hr + 1024 * (1 + d) + hh * 128 + cgp * 16 + 8);
      hraw[4] = *(const u32x4*)(hr + 3072 + hh * 128 + vg * 16 + (cgp & 1) * 8);
    };
    auto prep = [&](int c) {
      const int buf = c & 1;
      float v[8];
#pragma unroll
      for (int half = 0; half < 2; ++half) {
        int cc = cgp * 16 + half * 8;
        unpack8(hraw[half], v);
        *(f32x4*)&sq[buf][pti][cc] = (f32x4){v[0], v[1], v[2], v[3]};
        *(f32x4*)&sq[buf][pti][cc + 4] = (f32x4){v[4], v[5], v[6], v[7]};
        unpack8(hraw[2 + half], v);
        *(f32x4*)&sk[buf][pti][cc] = (f32x4){v[0], v[1], v[2], v[3]};
        *(f32x4*)&sk[buf][pti][cc + 4] = (f32x4){v[4], v[5], v[6], v[7]};
      }
      if (cgp < 2) {
        unpack8(hraw[4], v);
        *(f32x4*)&svv[buf][pti][cgp * 8] = (f32x4){v[0], v[1], v[2], v[3]};
        *(f32x4*)&svv[buf][pti][cgp * 8 + 4] = (f32x4){v[4], v[5], v[6], v[7]};
      }
    };
    auto scan_steps = [&](int c) {
      const int buf = c & 1;
#pragma unroll 1
      for (int t0 = 0; t0 < 32; t0 += 16) {
        float ykeep = 0.f;
#pragma unroll
        for (int tt = 0; tt < 16; ++tt) {
          const int t = t0 + tt;
          f32x4 k0 = *(const f32x4*)&sk[buf][t][kg * 8], k1 = *(const f32x4*)&sk[buf][t][kg * 8 + 4];
          f32x4 q0 = *(const f32x4*)&sq[buf][t][kg * 8], q1 = *(const f32x4*)&sq[buf][t][kg * 8 + 4];
          float vv = svv[buf][t][rl];
          float kk[8] = {k0.x, k0.y, k0.z, k0.w, k1.x, k1.y, k1.z, k1.w};
          float qq[8] = {q0.x, q0.y, q0.z, q0.w, q1.x, q1.y, q1.z, q1.w};
          float o = 0.f;
#pragma unroll
          for (int e = 0; e < 8; ++e) {
            S[e] = (1.f - kk[e]) * S[e] + kk[e] * vv;
            o += S[e] * qq[e];
          }
          o = red16(o);
          ykeep = (kg == tt) ? o : ykeep;
        }
        syb[buf][t0 + kg][rl] = ykeep;
      }
    };
    auto flush = [&](int c) {
      const int buf = c & 1;
      int ti = tid >> 3, pr = tid & 7;
      int row = chunk_row(c, ti, d, b);
      unsigned o = pack2(syb[buf][ti][2 * pr], syb[buf][ti][2 * pr + 1]);
      *(unsigned*)(ydst + (size_t)row * yld + hh * 128 + vg * 16 + 2 * pr) = o;
    };
    __syncthreads();
    if (!is_scan) { issue(0); prep(0); issue(1); }
    __syncthreads();
    for (int c = 0; c < NCH; ++c) {
      if (is_scan) { if (c > 0) flush(c - 1); scan_steps(c); }
      else if (c + 1 < NCH) { prep(c + 1); issue(min(c + 2, NCH - 1)); }
      __syncthreads();
    }
    if (is_scan) flush(NCH - 1);
  }
}

DI void hgrn_readout_phase(const Params& P, int j) {
  const bf16_t* obw = (const bf16_t*)(P.ws + OFF_BIG + SZ_HG);
  bf16_t* yab = (bf16_t*)(P.ws + OFF_YAB);
  const int total = NR * 128;
  for (int task = blockIdx.x * NTHR + opaque_tid(); task < total; task += gridDim.x * NTHR) {
    int row = task >> 7, hc = task & 127;
    int col = hc * 8;
    float of[8], ob[8], o[8];
    unpack8(*(const u32x4*)(yab + (size_t)row * 2048 + 1024 + col), of);
    unpack8(*(const u32x4*)(obw + (size_t)row * 1024 + col), ob);
    float q = 0.f;
#pragma unroll
    for (int e = 0; e < 8; ++e) { o[e] = of[e] + ob[e]; q += o[e] * o[e]; }
    float rs = rsqrtf(red16(q) * (1.f / 128.f) + 1e-5f);
#pragma unroll
    for (int e = 0; e < 8; ++e) o[e] = o[e] * rs * P.hnorm_g[j * 128 + ((col + e) & 127)];
    *(u32x4*)(yab + (size_t)row * 2048 + 1024 + col) = pack8(o);
  }
}

DI void attn_phase(const Params& P, int j, bool need_ctx, char* smem, bool dry) {
  bf16_t(*sK)[64][72] = (bf16_t(*)[64][72])smem;
  bf16_t(*sV)[128][72] = (bf16_t(*)[128][72])(smem + 2 * 64 * 72 * 2);
  unsigned(*sO)[NTHR] = (unsigned(*)[NTHR])(smem + 2 * 64 * 72 * 2 + 2 * 128 * 72 * 2);
  const int tid = opaque_tid(), wave = tid >> 6, lane = tid & 63, r = lane & 31, h = lane >> 5;
  bf16_t* qbuf = (bf16_t*)(P.ws + OFF_YAB);
  const bf16_t* kbuf = (const bf16_t*)(P.ws + OFF_BIG);
  const bf16_t* vtb = (const bf16_t*)(P.ws + OFF_BIG + SZ_N2048);
  const float lam = ((const float*)(P.ws + OFF_LAM))[j];
  const float lam_init = P.lam_init[j];
  const float CS = 0.125f * 1.4426950408889634f;
  const int nitems = 1024 + (need_ctx ? 32 : 0);
  for (int item = blockIdx.x; item < nitems; item += gridDim.x) {
    int b, head, qrow0, ntiles;
    if (item < 1024) {
      int round = item >> 8, slot = item & 255, xcd = slot & 7, qb = slot >> 3;
      int bh = round * 8 + xcd;
      b = bh >> 4; head = bh & 15; qrow0 = b * 8192 + qb * 256; ntiles = 132;
    } else {
      int it = item - 1024; head = it & 15; b = it >> 4; qrow0 = NLAT + b * 256; ntiles = 4;
    }
    const int qrow = qrow0 + wave * 32 + r;
    const bf16_t* vbase = vtb + (size_t)(b * 16 + head) * 128 * 8448;
#pragma unroll 1
    for (int m = 0; m < 2; ++m) {
      bf16x8 qf[4];
#pragma unroll
      for (int s = 0; s < 4; ++s) qf[s] = *(const bf16x8*)(qbuf + (size_t)qrow * 2048 + head * 128 + m * 64 + 16 * s + 8 * h);
      f32x16 oacc[4];
#pragma unroll
      for (int vt = 0; vt < 4; ++vt)
#pragma unroll
        for (int i = 0; i < 16; ++i) oacc[vt][i] = 0.f;
      float mrun = -1e30f, lsum = 0.f;
      const int kcol = head * 128 + m * 64 + (tid & 7) * 8;
      auto kaddr = [&](int tile) -> const bf16_t* {
        int kidx = tile * 64 + (tid >> 3);
        int krow = kidx < 256 ? (NLAT + b * 256 + kidx) : (b * 8192 + kidx - 256);
        return kbuf + (size_t)krow * 2048 + kcol;
      };
      const bf16_t* vp = vbase + (size_t)(tid >> 3) * 8448 + (tid & 7) * 8;
      const int srow = tid >> 3, scol = (tid & 7) * 8;
      __syncthreads();
      {
        u32x4 k0 = *(const u32x4*)kaddr(0), k1 = *(const u32x4*)kaddr(1);
        u32x4 v0 = *(const u32x4*)(vp), v1 = *(const u32x4*)(vp + (size_t)64 * 8448);
        *(u32x4*)&sK[0][srow][scol] = k0;
        *(u32x4*)&sK[1][srow][scol] = k1;
        *(u32x4*)&sV[0][srow][scol] = v0;
        *(u32x4*)&sV[0][64 + srow][scol] = v1;
      }
      __syncthreads();
      f32x16 sA_[2], sB_[2];
      auto qk = [&](f32x16* sacc, int buf) {
#pragma unroll
        for (int kt = 0; kt < 2; ++kt)
#pragma unroll
          for (int i = 0; i < 16; ++i) sacc[kt][i] = 0.f;
#pragma unroll
        for (int s = 0; s < 4; ++s)
#pragma unroll
          for (int kt = 0; kt < 2; ++kt) {
            bf16x8 a = *(const bf16x8*)&sK[buf][kt * 32 + r][16 * s + 8 * h];
            sacc[kt] = MFMA32(a, qf[s], sacc[kt]);
          }
      };
      auto step = [&](f32x16* cur, f32x16* nxt, int tile) {
        const int buf = tile & 1;
        const int tk = min(tile + 2, ntiles - 1), tv = min(tile + 1, ntiles - 1);
        u32x4 rk = *(const u32x4*)kaddr(tk);
        u32x4 rv0 = *(const u32x4*)(vp + tv * 64);
        u32x4 rv1 = *(const u32x4*)(vp + (size_t)64 * 8448 + tv * 64);
        qk(nxt, buf ^ 1);
        float mx = cur[0][0];
#pragma unroll
        for (int kt = 0; kt < 2; ++kt)
#pragma unroll
          for (int i = 0; i < 16; ++i) mx = fmaxf(mx, cur[kt][i]);
        mx = fmaxf(mx, __shfl_xor(mx, 32));
        float mnew = fmaxf(mrun, mx);
        float alpha = __builtin_amdgcn_exp2f((mrun - mnew) * CS);
        if (__any(alpha != 1.f)) {
          lsum *= alpha;
#pragma unroll
          for (int vt = 0; vt < 4; ++vt)
#pragma unroll
            for (int i = 0; i < 16; ++i) oacc[vt][i] *= alpha;
        }
        mrun = mnew;
        const float mb = mnew * CS;
        bf16x8 pb[2][2];
#pragma unroll
        for (int kt = 0; kt < 2; ++kt)
#pragma unroll
          for (int s2 = 0; s2 < 2; ++s2) {
            float pv[8];
#pragma unroll
            for (int e = 0; e < 8; ++e) { pv[e] = __builtin_amdgcn_exp2f(cur[kt][8 * s2 + e] * CS - mb); lsum += pv[e]; }
            u32x4 pk = pack8(pv);
            pb[kt][s2] = __builtin_bit_cast(bf16x8, pk);
          }
        __builtin_amdgcn_s_setprio(2);
#pragma unroll
        for (int kt = 0; kt < 2; ++kt)
#pragma unroll
          for (int s2 = 0; s2 < 2; ++s2)
#pragma unroll
            for (int vt = 0; vt < 4; ++vt) {
              const bf16_t* vrow = &sV[buf][vt * 32 + r][kt * 32 + 16 * s2 + 4 * h];
              s16x4 lo = *(const s16x4*)vrow;
              s16x4 hi = *(const s16x4*)(vrow + 8);
              bf16x8 a = __builtin_shufflevector(lo, hi, 0, 1, 2, 3, 4, 5, 6, 7);
              oacc[vt] = MFMA32(a, pb[kt][s2], oacc[vt]);
            }
        __builtin_amdgcn_s_setprio(0);
        *(u32x4*)&sK[buf][srow][scol] = rk;
        *(u32x4*)&sV[buf ^ 1][srow][scol] = rv0;
        *(u32x4*)&sV[buf ^ 1][64 + srow][scol] = rv1;
        __syncthreads();
      };
      qk(sA_, 0);
      for (int tile = 0; tile < ntiles; tile += 2) {
        step(sA_, sB_, tile);
        step(sB_, sA_, tile + 1);
      }
      float ltot = lsum + __shfl_xor(lsum, 32);
      float inv = 1.f / ltot;
      if (m == 0) {
#pragma unroll
        for (int vt = 0; vt < 4; ++vt)
#pragma unroll
          for (int i = 0; i < 8; ++i) sO[vt * 8 + i][tid] = pack2(oacc[vt][2 * i] * inv, oacc[vt][2 * i + 1] * inv);
      } else {
        float ss = 0.f;
#pragma unroll
        for (int vt = 0; vt < 4; ++vt)
#pragma unroll
          for (int i = 0; i < 8; ++i) {
            unsigned u = sO[vt * 8 + i][tid];
            float o0 = bflo(u) - lam * oacc[vt][2 * i] * inv, o1 = bfhi(u) - lam * oacc[vt][2 * i + 1] * inv;
            oacc[vt][2 * i] = o0; oacc[vt][2 * i + 1] = o1; ss += o0 * o0 + o1 * o1;
          }
        ss += __shfl_xor(ss, 32);
        float rs = rsqrtf(ss * (1.f / 128.f) + 1e-5f) * (1.f - lam_init);
#pragma unroll
        for (int vt = 0; vt < 4; ++vt)
#pragma unroll
          for (int g4 = 0; g4 < 4; ++g4) {
            int v0 = vt * 32 + 8 * g4 + 4 * h;
            float4 gg = *(const float4*)(P.subln_g + j * 128 + v0);
            u32x2 o;
            o.x = pack2(oacc[vt][4 * g4 + 0] * rs * gg.x, oacc[vt][4 * g4 + 1] * rs * gg.y);
            o.y = pack2(oacc[vt][4 * g4 + 2] * rs * gg.z, oacc[vt][4 * g4 + 3] * rs * gg.w);
            if (!dry) *(u32x2*)(qbuf + (size_t)qrow * 2048 + head * 128 + v0) = o;
          }
      }
    }
  }
}

DI void run_phase(const Params& P, int ph, char* smem, bool dry) {
  const bf16_t* wt = (const bf16_t*)(P.ws + OFF_WT);
  const bf16_t* hb = (const bf16_t*)(P.ws + OFF_HB);
  const bf16_t* yab = (const bf16_t*)(P.ws + OFF_YAB);
  if (ph == 0) { prologue_phase(P, smem); return; }
  if (ph == 1) { ln_phase(P, 0, false, true, 0); return; }
  int q = ph - 2;
  int layer, sub;
  if (q < 9) { layer = 0; sub = q; }
  else if (q < 14) { layer = 1; sub = q - 9; }
  else if (q < 23) { layer = 2; sub = q - 14; }
  else { layer = 3; sub = q - 23; }
  const int j = layer >> 1;
  if ((layer & 1) == 0) {
    switch (sub) {
      case 0: gemm_phase<EPI_R>(P, hb, 1024, wt, 13, 1024, layer, smem); break;
      case 1: rwkv_scan_phase(P, j, smem); break;
      case 2: rwkv_readout_phase(P, j); break;
      case 3: gemm_phase<EPI_H>(P, hb, 1024, wt + (size_t)3328 * 1024, 16, 1024, layer, smem); break;
      case 4: hgrn_scan_phase(P, j, smem); break;
      case 5: hgrn_readout_phase(P, j); break;
      case 6: gemm_phase<EPI_G>(P, hb, 1024, wt + (size_t)7424 * 1024, 8, 1024, layer, smem); break;
      case 7: gemm_phase<EPI_O>(P, yab, 2048, wt + (size_t)9472 * 1024, 4, 2048, layer, smem); break;
      default:
        ln_phase(P, layer, true, true, layer + 1);
        convert_layer_weights(P, layer + 1, smem);
        break;
    }
  } else {
    switch (sub) {
      case 0:
        gemm_phase<EPI_QK>(P, hb, 1024, wt, 16, 1024, layer, smem);
        gemm_phase<EPI_V>(P, hb, 1024, wt + (size_t)4096 * 1024, 8, 1024, layer, smem);
        break;
      case 1: attn_phase(P, j, layer < 3, smem, dry); break;
      case 2: gemm_phase<EPI_G>(P, hb, 1024, wt + (size_t)6144 * 1024, 8, 1024, layer, smem, layer < 3 ? 66 : 64); break;
      case 3: gemm_phase<EPI_O>(P, yab, 2048, wt + (size_t)8192 * 1024, 4, 2048, layer, smem, layer < 3 ? 66 : 64); break;
      default:
        ln_phase(P, layer, true, layer < 3, layer + 1);
        if (layer < 3) convert_layer_weights(P, layer + 1, smem);
        break;
    }
  }
}
constexpr int NPHASES = 30;

__global__ void __launch_bounds__(NTHR) mega_kernel(Params P, int lo, int hi) {
  __shared__ __attribute__((aligned(16))) char smem[147456];
  cg::grid_group grid = cg::this_grid();
  for (int ph = lo; ph < hi; ++ph) {
    int reps = 1;
#ifdef PROBE_DUP_SCAN
    if (ph == 3 || ph == 6 || ph == 17 || ph == 20) reps = 2;
#endif
#ifdef PROBE_DUP_ATTN
    if (ph == 12 || ph == 26) reps = 2;
#endif
#ifdef PROBE_DUP_GEMM_IN
    if (ph == 2 || ph == 5 || ph == 11 || ph == 16 || ph == 19 || ph == 25) reps = 2;
#endif
    for (int rep = 0; rep < reps; ++rep) {
      run_phase(P, ph, smem, rep + 1 < reps);
      if (rep + 1 < reps) grid.sync();
    }
    if (ph + 1 < hi) grid.sync();
  }
}

extern "C" void kernel_launch(void* const* d_in, const int* in_sizes, int n_in, void* d_out, int out_size,
                              void* d_ws, size_t ws_size, hipStream_t stream) {
  if (ws_size < WS_NEEDED) { fprintf(stderr, "workspace too small: %zu < %zu\n", ws_size, WS_NEEDED); return; }
  Params p{};
  const float** pp = (const float**)&p;
  for (int i = 0; i < 27; ++i) pp[i] = (const float*)d_in[i];
  p.out = (float*)d_out;
  p.ws = (char*)d_ws;
  p.lam_init[0] = (float)(0.8 - 0.6 * exp(-0.3 * 1.0));
  p.lam_init[1] = (float)(0.8 - 0.6 * exp(-0.3 * 3.0));
  static int grid_blocks = 0;
  if (!grid_blocks) {
    int dev = 0, cus = 0, per_cu = 0;
    hipGetDevice(&dev);
    hipDeviceGetAttribute(&cus, hipDeviceAttributeMultiprocessorCount, dev);
    hipOccupancyMaxActiveBlocksPerMultiprocessor(&per_cu, mega_kernel, NTHR, 0);
    if (per_cu < 1) per_cu = 1;
    grid_blocks = cus * per_cu;
  }
  int lo = 0, hi = NPHASES;
  void* args[] = {&p, &lo, &hi};
  hipError_t e = hipLaunchCooperativeKernel((void*)mega_kernel, dim3(grid_blocks), dim3(NTHR), args, 0, stream);
  if (e != hipSuccess) fprintf(stderr, "cooperative launch failed: %s (grid %d)\n", hipGetErrorString(e), grid_blocks);
}
```

```cpp
#include <hip/hip_runtime.h>
#include <hip/hip_cooperative_groups.h>
#include <cstdio>
#include <cmath>
namespace cg = cooperative_groups;

#define DI __device__ __forceinline__
typedef unsigned short bf16_t;
typedef __attribute__((ext_vector_type(8))) short bf16x8;
typedef __attribute__((ext_vector_type(4))) short s16x4;
typedef __attribute__((ext_vector_type(16))) float f32x16;
typedef __attribute__((ext_vector_type(4))) float f32x4;
typedef __attribute__((ext_vector_type(4))) unsigned u32x4;
typedef __attribute__((ext_vector_type(2))) unsigned u32x2;
typedef __attribute__((ext_vector_type(2))) float f32x2;
typedef __attribute__((ext_vector_type(2))) __bf16 bf16x2v;
#define MFMA32(a, b, c) __builtin_amdgcn_mfma_f32_32x32x16_bf16((a), (b), (c), 0, 0, 0)

constexpr int NR = 16896, NLAT = 16384;
constexpr int NTHR = 512;
constexpr float ALPHA = 1.681792830507429f;

constexpr size_t SZ_WT   = 23592960;
constexpr size_t OFF_WT  = 0;
constexpr size_t OFF_HB  = OFF_WT + SZ_WT;
constexpr size_t OFF_YAB = OFF_HB + (size_t)NR * 1024 * 2;
constexpr size_t OFF_XCTX = OFF_YAB + (size_t)NR * 2048 * 2;
constexpr size_t OFF_MOD = OFF_XCTX + 512 * 1024 * 4;
constexpr size_t OFF_LB  = OFF_MOD + 4 * 3 * 3072 * 4;
constexpr size_t OFF_ROPE = OFF_LB + 2 * 2 * 1024 * 4;
constexpr size_t OFF_LAM = OFF_ROPE + 128 * 16 * 2 * 4;
constexpr size_t OFF_BIG = OFF_LAM + 256;
constexpr size_t SZ_PRWKV = (size_t)NR * 3328 * 2;
constexpr size_t SZ_HG = (size_t)NR * 4096 * 2;
constexpr size_t SZ_N2048 = (size_t)NR * 2048 * 2;
constexpr size_t WS_NEEDED = OFF_BIG + SZ_HG + (size_t)NR * 1024 * 2;

struct Params {
  const float *x, *c, *ctx, *c_ctx, *ada_w, *ada_b, *ln_g, *ln_b, *even_w_in, *even_w_out;
  const float *mu_prev, *mu_next, *w0, *w2, *a0, *a2, *k_k, *k_a, *r_k, *lnx_g, *lnx_b, *lb_logits, *hnorm_g;
  const float *odd_w_in, *odd_w_out, *diff_lambda, *subln_g;
  float* out;
  char* ws;
  float lam_init[2];
};

DI unsigned pack2(float a, float b) { f32x2 v = {a, b}; bf16x2v r = __builtin_convertvector(v, bf16x2v); return __builtin_bit_cast(unsigned, r); }
DI bf16_t f2bf(float x) { return (bf16_t)(pack2(x, 0.f) & 0xffffu); }
DI float bf2f(bf16_t h) { return __uint_as_float(((unsigned)h) << 16); }
DI float bflo(unsigned u) { return __uint_as_float(u << 16); }
DI float bfhi(unsigned u) { return __uint_as_float(u & 0xffff0000u); }
DI int crow(int reg, int h) { return (reg & 3) + 8 * (reg >> 2) + 4 * h; }
DI int opaque_tid() { int t = threadIdx.x; asm volatile("" : "+v"(t)); return t; }
DI float sigmoidf_(float z) { return __builtin_amdgcn_rcpf(1.f + __expf(-z)); }
DI float siluf_(float z) { return z * __builtin_amdgcn_rcpf(1.f + __expf(-z)); }

template <int CTRL> DI float dpp_mov(float x) {
  return __int_as_float(__builtin_amdgcn_update_dpp(0, __float_as_int(x), CTRL, 0xf, 0xf, true));
}
DI float red16(float x) {
  x += dpp_mov<0xB1>(x); x += dpp_mov<0x4E>(x); x += dpp_mov<0x141>(x); x += dpp_mov<0x140>(x); return x;
}
DI float red8(float x) {
  x += dpp_mov<0xB1>(x); x += dpp_mov<0x4E>(x); x += dpp_mov<0x141>(x); return x;
}
DI float wave_sum(float x) {
  for (int o = 32; o > 0; o >>= 1) x += __shfl_xor(x, o);
  return x;
}

DI void unpack8(u32x4 u, float* o) {
  o[0] = bflo(u.x); o[1] = bfhi(u.x); o[2] = bflo(u.y); o[3] = bfhi(u.y);
  o[4] = bflo(u.z); o[5] = bfhi(u.z); o[6] = bflo(u.w); o[7] = bfhi(u.w);
}
DI u32x4 pack8(const float* v) { u32x4 r; r.x = pack2(v[0], v[1]); r.y = pack2(v[2], v[3]); r.z = pack2(v[4], v[5]); r.w = pack2(v[6], v[7]); return r; }

DI void load_shift8(const bf16_t* __restrict__ p, int row, bool hasprev, bool hasnext, int col,
                    const float* __restrict__ mup, const float* __restrict__ mun, float* o) {
  const u32x4 z4 = {0u, 0u, 0u, 0u};
  u32x4 cu = *(const u32x4*)(p + (size_t)row * 3328 + col);
  u32x4 pv = hasprev ? *(const u32x4*)(p + (size_t)(row - 1) * 3328 + col) : z4;
  u32x4 nx = hasnext ? *(const u32x4*)(p + (size_t)(row + 1) * 3328 + col) : z4;
  float4 mp0 = *(const float4*)(mup + col), mp1 = *(const float4*)(mup + col + 4);
  float4 mn0 = *(const float4*)(mun + col), mn1 = *(const float4*)(mun + col + 4);
  float c[8], a[8], b[8];
  unpack8(cu, c); unpack8(pv, a); unpack8(nx, b);
  float mp[8] = {mp0.x, mp0.y, mp0.z, mp0.w, mp1.x, mp1.y, mp1.z, mp1.w};
  float mn[8] = {mn0.x, mn0.y, mn0.z, mn0.w, mn1.x, mn1.y, mn1.z, mn1.w};
#pragma unroll
  for (int e = 0; e < 8; ++e) o[e] = c[e] + mp[e] * (a[e] - c[e]) + mn[e] * (b[e] - c[e]);
}

DI void row_seg(int row, int& pos, int& seglen) {
  if (row < NLAT) { pos = row & 8191; seglen = 8192; } else { pos = (row - NLAT) & 255; seglen = 256; }
}
DI int chunk_row(int c, int i, int d, int b) {
  int seglen, segbase, cc;
  if (c < 8) { seglen = 256; segbase = NLAT + b * 256; cc = c; } else { seglen = 8192; segbase = b * 8192; cc = c - 8; }
  int pos = cc * 32 + i;
  if (d) pos = seglen - 1 - pos;
  return segbase + pos;
}

DI void convert_wt(const float* __restrict__ W, int K, int N, bf16_t* __restrict__ Wt, char* smem) {
  float(*tile)[65] = (float(*)[65])smem;
  const int tid = opaque_tid();
  const int tilesK = K / 64, tilesN = N / 64;
  for (int t = blockIdx.x; t < tilesK * tilesN; t += gridDim.x) {
    int tk = t % tilesK, tn = t / tilesK;
    __syncthreads();
    {
      int kr = tid >> 4, nc = (tid & 15) * 4;
#pragma unroll
      for (int i = 0; i < 2; ++i) {
        float4 v = *(const float4*)(W + (size_t)(tk * 64 + kr + 32 * i) * N + tn * 64 + nc);
        tile[kr + 32 * i][nc + 0] = v.x; tile[kr + 32 * i][nc + 1] = v.y; tile[kr + 32 * i][nc + 2] = v.z; tile[kr + 32 * i][nc + 3] = v.w;
      }
    }
    __syncthreads();
    {
      int n = tid >> 3, kc = (tid & 7) * 8;
      float v[8];
#pragma unroll
      for (int e = 0; e < 8; ++e) v[e] = tile[kc + e][n];
      *(u32x4*)(Wt + (size_t)(tn * 64 + n) * K + tk * 64 + kc) = pack8(v);
    }
  }
}

DI void convert_layer_weights(const Params& P, int layer, char* smem) {
  bf16_t* wt = (bf16_t*)(P.ws + OFF_WT);
  int j = layer >> 1;
  if ((layer & 1) == 0) {
    convert_wt(P.even_w_in + (size_t)j * 1024 * 9472, 1024, 9472, wt, smem);
    convert_wt(P.even_w_out + (size_t)j * 2048 * 1024, 2048, 1024, wt + (size_t)9472 * 1024, smem);
  } else {
    convert_wt(P.odd_w_in + (size_t)j * 1024 * 8192, 1024, 8192, wt, smem);
    convert_wt(P.odd_w_out + (size_t)j * 2048 * 1024, 2048, 1024, wt + (size_t)8192 * 1024, smem);
  }
}

DI void prologue_phase(const Params& P, char* smem) {
  const int tid = opaque_tid();
  float* mod = (float*)(P.ws + OFF_MOD);
  {
    float* sc = (float*)smem;
    float* red = sc + 3072;
    for (int task = blockIdx.x; task < 192; task += gridDim.x) {
      int layer = task / 48, cgp = task % 48;
      __syncthreads();
      for (int i = tid; i < 3072; i += NTHR) {
        int rc = i >> 10, k = i & 1023;
        float cv = rc < 2 ? P.c[rc * 1024 + k] : P.c_ctx[k];
        sc[i] = siluf_(cv);
      }
      __syncthreads();
      int col = cgp * 64 + (tid & 63), kg = tid >> 6;
      float a0 = 0.f, a1 = 0.f, a2 = 0.f;
      const float* wp = P.ada_w + ((size_t)layer * 1024 + kg * 128) * 3072 + col;
#pragma unroll 8
      for (int k = 0; k < 128; ++k) {
        float w = wp[(size_t)k * 3072];
        a0 += sc[kg * 128 + k] * w; a1 += sc[1024 + kg * 128 + k] * w; a2 += sc[2048 + kg * 128 + k] * w;
      }
      red[(kg * 3 + 0) * 64 + (tid & 63)] = a0; red[(kg * 3 + 1) * 64 + (tid & 63)] = a1; red[(kg * 3 + 2) * 64 + (tid & 63)] = a2;
      __syncthreads();
      if (tid < 192) {
        int rc = tid >> 6, l = tid & 63;
        float s = 0.f;
        for (int g = 0; g < 8; ++g) s += red[(g * 3 + rc) * 64 + l];
        int cc = cgp * 64 + l;
        mod[((size_t)layer * 3 + rc) * 3072 + cc] = s + P.ada_b[layer * 3072 + cc];
      }
    }
  }
  const int gtid = blockIdx.x * NTHR + tid, gstride = gridDim.x * NTHR;
  {
    float* lb = (float*)(P.ws + OFF_LB);
    for (int i = gtid; i < 2048; i += gstride) {
      float l0 = P.lb_logits[i], l1 = P.lb_logits[2048 + i];
      lb[i] = 0.f; lb[2048 + i] = 1.f / (1.f + expf(l0 - l1));
    }
  }
  {
    float* rope = (float*)(P.ws + OFF_ROPE);
    for (int i = gtid; i < 2048; i += gstride) {
      int pos = i >> 4, jj = i & 15;
      float inv = powf(10000.f, -(float)jj / 16.f);
      float ang = (float)pos * inv;
      rope[2 * i] = cosf(ang); rope[2 * i + 1] = sinf(ang);
    }
  }
  if (blockIdx.x == 0 && tid < 128) {
    int j = tid >> 6, l = tid & 63;
    const float* lp = P.diff_lambda + j * 256;
    float s01 = wave_sum(lp[l] * lp[64 + l]);
    float s23 = wave_sum(lp[128 + l] * lp[192 + l]);
    if (l == 0) ((float*)(P.ws + OFF_LAM))[j] = expf(s01) - expf(s23) + P.lam_init[j];
  }
  {
    const float4* xs = (const float4*)P.x; float4* xd = (float4*)P.out;
    for (int i = gtid; i < NLAT * 256; i += gstride) xd[i] = xs[i];
    const float4* cs = (const float4*)P.ctx; float4* cd = (float4*)(P.ws + OFF_XCTX);
    for (int i = gtid; i < 512 * 256; i += gstride) cd[i] = cs[i];
  }
  convert_layer_weights(P, 0, smem);
}

DI void ln_phase(const Params& P, int layer, bool do_ln, bool write_hb, int next_layer) {
  const int tid = opaque_tid(), wave = tid >> 6, lane = tid & 63;
  const float* mod = (const float*)(P.ws + OFF_MOD);
  bf16_t* hb = (bf16_t*)(P.ws + OFF_HB);
  float* xctx = (float*)(P.ws + OFF_XCTX);
  for (int row = blockIdx.x * 8 + wave; row < NR; row += gridDim.x * 8) {
    float* xp = row < NLAT ? P.out + (size_t)row * 1024 : xctx + (size_t)(row - NLAT) * 1024;
    float4 v[4];
#pragma unroll
    for (int i = 0; i < 4; ++i) v[i] = ((float4*)xp)[lane + 64 * i];
    if (do_ln) {
      float s = 0.f;
#pragma unroll
      for (int i = 0; i < 4; ++i) s += v[i].x + v[i].y + v[i].z + v[i].w;
      float mu = wave_sum(s) * (1.f / 1024.f);
      float q = 0.f;
#pragma unroll
      for (int i = 0; i < 4; ++i) {
        float a = v[i].x - mu, b = v[i].y - mu, c = v[i].z - mu, d = v[i].w - mu;
        q += a * a + b * b + c * c + d * d;
      }
      float rs = rsqrtf(wave_sum(q) * (1.f / 1024.f) + 1e-5f);
#pragma unroll
      for (int i = 0; i < 4; ++i) {
        float4 g = ((const float4*)(P.ln_g + layer * 1024))[lane + 64 * i];
        float4 b = ((const float4*)(P.ln_b + layer * 1024))[lane + 64 * i];
        v[i].x = (v[i].x - mu) * rs * g.x + b.x; v[i].y = (v[i].y - mu) * rs * g.y + b.y;
        v[i].z = (v[i].z - mu) * rs * g.z + b.z; v[i].w = (v[i].w - mu) * rs * g.w + b.w;
        ((float4*)xp)[lane + 64 * i] = v[i];
      }
    }
    if (write_hb) {
      int rc = row < NLAT ? (row >> 13) : 2;
      const float* mp = mod + ((size_t)next_layer * 3 + rc) * 3072;
#pragma unroll
      for (int i = 0; i < 4; ++i) {
        float4 sh = ((const float4*)mp)[lane + 64 * i];
        float4 sc = ((const float4*)(mp + 1024))[lane + 64 * i];
        uint2 o;
        o.x = pack2(v[i].x * (1.f + sc.x) + sh.x, v[i].y * (1.f + sc.y) + sh.y);
        o.y = pack2(v[i].z * (1.f + sc.z) + sh.z, v[i].w * (1.f + sc.w) + sh.w);
        *(uint2*)(hb + (size_t)row * 1024 + (lane + 64 * i) * 4) = o;
      }
    }
  }
}

enum { EPI_R = 0, EPI_H = 1, EPI_G = 2, EPI_O = 3, EPI_QK = 4, EPI_V = 5 };

template <int EPI>
DI void gemm_phase(const Params& P, const bf16_t* __restrict__ A, int lda, const bf16_t* __restrict__ Bt,
                   int Nt, int K, int layer, char* smem, int Mt = NR / 256) {
  bf16_t(*sA)[256][72] = (bf16_t(*)[256][72])smem;
  bf16_t(*sB)[256][72] = (bf16_t(*)[256][72])(smem + 2 * 256 * 72 * 2);
  const int tid = opaque_tid(), wave = tid >> 6, lane = tid & 63, r = lane & 31, h = lane >> 5;
  const int wm = wave >> 2, wn = wave & 3;
  const int j = layer >> 1;
  const int nk = K / 64;
  const int T = Mt * Nt;
  const bool swz = (gridDim.x == 256);
  for (int base = 0; base < T; base += gridDim.x) {
    const int v = base + (swz ? ((blockIdx.x & 7) * 32 + (blockIdx.x >> 3)) : blockIdx.x);
    if (v >= T) break;
    const int grp = v / (Mt * 4);
    const int nw = min(4, Nt - grp * 4);
    const int w = v - grp * Mt * 4;
    const int tm = w / nw, tn = grp * 4 + (w - tm * nw);
    const int m0 = tm * 256, n0 = tn * 256;
    constexpr bool swap = (EPI == EPI_V);
    f32x16 acc[4][2];
#pragma unroll
    for (int mi = 0; mi < 4; ++mi)
#pragma unroll
      for (int ni = 0; ni < 2; ++ni)
#pragma unroll
        for (int i = 0; i < 16; ++i) acc[mi][ni][i] = 0.f;
    const char* Au = (const char*)(A + (size_t)m0 * lda);
    const char* Bu = (const char*)(Bt + (size_t)n0 * K);
    const unsigned aoff = ((unsigned)(tid >> 3) * (unsigned)lda + (unsigned)(tid & 7) * 8u) * 2u;
    const unsigned boff = ((unsigned)(tid >> 3) * (unsigned)K + (unsigned)(tid & 7) * 8u) * 2u;
    u32x4 ra[4], rb[4];
#pragma unroll
    for (int i = 0; i < 4; ++i) {
      ra[i] = *(const u32x4*)(Au + (size_t)i * 128 * lda + aoff);
      rb[i] = *(const u32x4*)(Bu + (size_t)i * 128 * K + boff);
    }
    __syncthreads();
#pragma unroll
    for (int i = 0; i < 4; ++i) {
      *(u32x4*)&sA[0][(tid >> 3) + 64 * i][(tid & 7) * 8] = ra[i];
      *(u32x4*)&sB[0][(tid >> 3) + 64 * i][(tid & 7) * 8] = rb[i];
    }
    __syncthreads();
    for (int kt = 0; kt < nk; ++kt) {
      const int cb = kt & 1;
      if (kt + 1 < nk) {
#pragma unroll
        for (int i = 0; i < 4; ++i) {
          ra[i] = *(const u32x4*)(Au + ((size_t)i * 128 * lda + (kt + 1) * 128) + aoff);
          rb[i] = *(const u32x4*)(Bu + ((size_t)i * 128 * K + (kt + 1) * 128) + boff);
        }
      }
      __builtin_amdgcn_sched_barrier(0);
      {
        bf16x8 af[2][4], bfr[2][2];
#pragma unroll
        for (int mi = 0; mi < 4; ++mi) af[0][mi] = *(const bf16x8*)&sA[cb][wm * 128 + mi * 32 + r][8 * h];
#pragma unroll
        for (int ni = 0; ni < 2; ++ni) bfr[0][ni] = *(const bf16x8*)&sB[cb][wn * 64 + ni * 32 + r][8 * h];
#pragma unroll
        for (int s = 0; s < 4; ++s) {
          const int cs = s & 1, ns = cs ^ 1;
          if (s < 3) {
#pragma unroll
            for (int mi = 0; mi < 4; ++mi) af[ns][mi] = *(const bf16x8*)&sA[cb][wm * 128 + mi * 32 + r][16 * (s + 1) + 8 * h];
#pragma unroll
            for (int ni = 0; ni < 2; ++ni) bfr[ns][ni] = *(const bf16x8*)&sB[cb][wn * 64 + ni * 32 + r][16 * (s + 1) + 8 * h];
          }
          if (swap) {
#pragma unroll
            for (int mi = 0; mi < 4; ++mi)
#pragma unroll
              for (int ni = 0; ni < 2; ++ni) acc[mi][ni] = MFMA32(bfr[cs][ni], af[cs][mi], acc[mi][ni]);
          } else {
#pragma unroll
            for (int mi = 0; mi < 4; ++mi)
#pragma unroll
              for (int ni = 0; ni < 2; ++ni) acc[mi][ni] = MFMA32(af[cs][mi], bfr[cs][ni], acc[mi][ni]);
          }
        }
      }
      if (kt + 1 < nk) {
#pragma unroll
        for (int i = 0; i < 4; ++i) {
          *(u32x4*)&sA[cb ^ 1][(tid >> 3) + 64 * i][(tid & 7) * 8] = ra[i];
          *(u32x4*)&sB[cb ^ 1][(tid >> 3) + 64 * i][(tid & 7) * 8] = rb[i];
        }
      }
      __syncthreads();
    }
    if (EPI == EPI_R) {
      bf16_t* dst = (bf16_t*)(P.ws + OFF_BIG);
#pragma unroll
      for (int mi = 0; mi < 4; ++mi)
#pragma unroll
        for (int ni = 0; ni < 2; ++ni)
#pragma unroll
          for (int i = 0; i < 16; ++i) {
            int row = m0 + wm * 128 + mi * 32 + crow(i, h), col = n0 + wn * 64 + ni * 32 + r;
            dst[(size_t)row * 3328 + col] = f2bf(acc[mi][ni][i]);
          }
    } else if (EPI == EPI_H) {
      bf16_t* dst = (bf16_t*)(P.ws + OFF_BIG);
      const float* lb = (const float*)(P.ws + OFF_LB);
      const int region = n0 >> 10;
#pragma unroll
      for (int mi = 0; mi < 4; ++mi)
#pragma unroll
        for (int ni = 0; ni < 2; ++ni) {
          int col = n0 + wn * 64 + ni * 32 + r;
          float lbv = (region == 1 || region == 2) ? lb[(j * 2 + (region - 1)) * 1024 + (col & 1023)] : 0.f;
#pragma unroll
          for (int i = 0; i < 16; ++i) {
            int row = m0 + wm * 128 + mi * 32 + crow(i, h);
            float v = acc[mi][ni][i], o;
            if (region == 0) o = siluf_(v);
            else if (region == 3) o = v;
            else o = (1.f - lbv) * sigmoidf_(-v);
            dst[(size_t)row * 4096 + col] = f2bf(o);
          }
        }
    } else if (EPI == EPI_G) {
      bf16_t* yab = (bf16_t*)(P.ws + OFF_YAB);
#pragma unroll
      for (int mi = 0; mi < 4; ++mi)
#pragma unroll
        for (int ni = 0; ni < 2; ++ni)
#pragma unroll
          for (int i = 0; i < 16; ++i) {
            int row = m0 + wm * 128 + mi * 32 + crow(i, h), col = n0 + wn * 64 + ni * 32 + r;
            size_t idx = (size_t)row * 2048 + col;
            yab[idx] = f2bf(bf2f(yab[idx]) * siluf_(acc[mi][ni][i]));
          }
    } else if (EPI == EPI_O) {
      const float* mod = (const float*)(P.ws + OFF_MOD);
      const int rc = m0 < NLAT ? (m0 >> 13) : 2;
      float* xbase = m0 < NLAT ? P.out : ((float*)(P.ws + OFF_XCTX)) - (size_t)NLAT * 1024;
#pragma unroll
      for (int mi = 0; mi < 4; ++mi)
#pragma unroll
        for (int ni = 0; ni < 2; ++ni) {
          int col = n0 + wn * 64 + ni * 32 + r;
          float gate = mod[((size_t)layer * 3 + rc) * 3072 + 2048 + col];
#pragma unroll
          for (int i = 0; i < 16; ++i) {
            int row = m0 + wm * 128 + mi * 32 + crow(i, h);
            float* xp = xbase + (size_t)row * 1024 + col;
            *xp = ALPHA * (*xp) + gate * acc[mi][ni][i];
          }
        }
    } else {
      if (EPI == EPI_QK) {
        const float* rope = (const float*)(P.ws + OFF_ROPE);
        bf16_t* dst = n0 < 2048 ? (bf16_t*)(P.ws + OFF_YAB) : (bf16_t*)(P.ws + OFF_BIG);
        const int cofs = n0 < 2048 ? 0 : 2048;
        const bool lat = m0 < NLAT;
#pragma unroll
        for (int mi = 0; mi < 4; ++mi)
#pragma unroll
          for (int ni = 0; ni < 2; ++ni) {
            int col = n0 + wn * 64 + ni * 32 + r;
#pragma unroll
            for (int i = 0; i < 16; ++i) {
              int row = m0 + wm * 128 + mi * 32 + crow(i, h);
              float v = acc[mi][ni][i];
              float pr = __shfl_xor(v, 16);
              float o = v;
              if (lat) {
                int t = row & 8191;
                int pos = (ni == 0) ? (t >> 6) : (t & 63);
                float2 cs = *(const float2*)(rope + (pos * 16 + (r & 15)) * 2);
                o = (r & 16) ? (pr * cs.y + v * cs.x) : (v * cs.x - pr * cs.y);
              }
              dst[(size_t)row * 2048 + (col - cofs)] = f2bf(o);
            }
          }
      } else {
        const int bb = m0 < NLAT ? (m0 >> 13) : ((m0 - NLAT) >> 8);
        const int key0 = m0 < NLAT ? 256 + (m0 & 8191) : ((m0 - NLAT) & 255);
        char* vtu = (char*)((bf16_t*)(P.ws + OFF_BIG + SZ_N2048) + ((size_t)(bb * 2048 + n0) * 8448 + key0));
#pragma unroll
        for (int mi = 0; mi < 4; ++mi) {
          const unsigned lane_off = ((unsigned)(wn * 64 + 4 * h) * 8448u + (unsigned)(wm * 128 + mi * 32 + r)) * 2u;
#pragma unroll
          for (int ni = 0; ni < 2; ++ni)
#pragma unroll
            for (int i = 0; i < 16; ++i) {
              const size_t eo = (size_t)(ni * 32 + (i & 3) + 8 * (i >> 2)) * 8448u * 2u;
              *(bf16_t*)((vtu + eo) + (size_t)lane_off) = f2bf(acc[mi][ni][i]);
            }
        }
      }
    }
  }
}

DI void rwkv_scan_phase(const Params& P, int j, char* smem) {
  typedef float (*arr64)[32][64];
  arr64 sw = (arr64)smem;
  arr64 skk = (arr64)(smem + 16384);
  arr64 skka = (arr64)(smem + 2 * 16384);
  arr64 skd = (arr64)(smem + 3 * 16384);
  arr64 srr = (arr64)(smem + 4 * 16384);
  float(*svv)[32][16] = (float(*)[32][16])(smem + 5 * 16384);
  float(*syb)[32][16] = (float(*)[32][16])(smem + 5 * 16384 + 4096);
  float(*stk)[64] = (float(*)[64])(smem + 5 * 16384 + 8192);
  bf16_t(*twl)[72] = (bf16_t(*)[72])(smem + 5 * 16384 + 16384);
  bf16_t(*tal)[72] = (bf16_t(*)[72])(smem + 5 * 16384 + 16384 + 4608);

  const int tid = opaque_tid(), wave = tid >> 6, lane = tid & 63;
  const bool is_scan = wave < 4;
  const bf16_t* prw = (const bf16_t*)(P.ws + OFF_BIG);
  const float* mup = P.mu_prev + j * 3328;
  const float* mun = P.mu_next + j * 3328;
  constexpr int NCH = 264;

  for (int item = blockIdx.x; item < 256; item += gridDim.x) {
    const int rg = item & 3, d = (item >> 2) & 1, hh = (item >> 3) & 15, b = item >> 7;
    const int rl = (wave & 3) * 4 + ((lane >> 4) & 3), cgl = lane & 15;
    f32x4 S = {0.f, 0.f, 0.f, 0.f};
    const int ptid = tid - 256, pti = (ptid >> 3) & 31, cgp = ptid & 7;
    const int pw = (wave - 4) & 3, r = lane & 31, h = lane >> 5;
    bf16x8 bfr[4];
    float c0 = 0.f, c1 = 0.f;
    if (!is_scan) {
      const float* W2 = (pw < 2 ? P.w2 : P.a2) + (size_t)(j * 2 + d) * 64 * 1024;
      const int hcol = hh * 64 + (pw & 1) * 32 + r;
#pragma unroll
      for (int s = 0; s < 4; ++s)
#pragma unroll
        for (int e = 0; e < 8; ++e) bfr[s][e] = (short)f2bf(W2[(size_t)(16 * s + 8 * h + e) * 1024 + hcol]);
      c0 = (pw < 2 ? P.w0 : P.a0)[(j * 2 + d) * 1024 + hcol];
      c1 = P.k_a[j * 1024 + hcol];
    }
    bf16_t* ydst = d == 0 ? (bf16_t*)(P.ws + OFF_YAB) : (bf16_t*)(P.ws + OFF_BIG + SZ_PRWKV);
    const int yld = d == 0 ? 2048 : 1024;

    const int gcol[5] = {hh * 64 + cgp * 8, 1024 + hh * 64 + cgp * 8, 2048 + hh * 64 + cgp * 8, 3072 + d * 64 + cgp * 8, 3200 + d * 64 + cgp * 8};
    f32x4 kkv[2];
    u32x4 raw[5][3];
    float(*smu)[2][64] = (float(*)[2][64])(smem + 107520);
    if (!is_scan) {
      kkv[0] = *(const f32x4*)(P.k_k + j * 1024 + hh * 64 + cgp * 8); kkv[1] = *(const f32x4*)(P.k_k + j * 1024 + hh * 64 + cgp * 8 + 4);
    }
    auto issue = [&](int c) {
      int row = chunk_row(c, pti, d, b);
      int pos, seglen; row_seg(row, pos, seglen);
      bool hp = pos > 0, hn = pos < seglen - 1;
      const u32x4 z4 = {0u, 0u, 0u, 0u};
      const bf16_t* base = prw + (size_t)row * 3328;
#pragma unroll
      for (int g = 0; g < 5; ++g) {
        raw[g][0] = *(const u32x4*)(base + gcol[g]);
        raw[g][1] = hp ? *(const u32x4*)(base - 3328 + gcol[g]) : z4;
        raw[g][2] = hn ? *(const u32x4*)(base + 3328 + gcol[g]) : z4;
      }
    };
    auto shifted = [&](int g, float* o) {
      float cc[8], aa[8], bb[8];
      unpack8(raw[g][0], cc); unpack8(raw[g][1], aa); unpack8(raw[g][2], bb);
#pragma unroll
      for (int e = 0; e < 8; ++e) {
        float mp = smu[g][0][cgp * 8 + e], mn = smu[g][1][cgp * 8 + e];
        o[e] = cc[e] + mp * (aa[e] - cc[e]) + mn * (bb[e] - cc[e]);
      }
    };
    auto prep1 = [&](int c) {
      const int buf = c & 1;
      float v[8];
      shifted(0, v);
      *(f32x4*)&srr[buf][pti][cgp * 8] = (f32x4){v[0], v[1], v[2], v[3]};
      *(f32x4*)&srr[buf][pti][cgp * 8 + 4] = (f32x4){v[4], v[5], v[6], v[7]};
      shifted(1, v);
      *(f32x4*)&stk[pti][cgp * 8] = (f32x4){v[0], v[1], v[2], v[3]};
      *(f32x4*)&stk[pti][cgp * 8 + 4] = (f32x4){v[4], v[5], v[6], v[7]};
      {
        float kr[8] = {v[0] * kkv[0].x, v[1] * kkv[0].y, v[2] * kkv[0].z, v[3] * kkv[0].w, v[4] * kkv[1].x, v[5] * kkv[1].y, v[6] * kkv[1].z, v[7] * kkv[1].w};
        float ss = 0.f;
#pragma unroll
        for (int e = 0; e < 8; ++e) ss += kr[e] * kr[e];
        ss = red8(ss);
        float rn = rsqrtf(ss + 1e-12f);
        *(f32x4*)&skk[buf][pti][cgp * 8] = (f32x4){kr[0] * rn, kr[1] * rn, kr[2] * rn, kr[3] * rn};
        *(f32x4*)&skk[buf][pti][cgp * 8 + 4] = (f32x4){kr[4] * rn, kr[5] * rn, kr[6] * rn, kr[7] * rn};
      }
      shifted(2, v);
      if ((cgp >> 1) == rg) {
        *(f32x4*)&svv[buf][pti][(cgp & 1) * 8] = (f32x4){v[0], v[1], v[2], v[3]};
        *(f32x4*)&svv[buf][pti][(cgp & 1) * 8 + 4] = (f32x4){v[4], v[5], v[6], v[7]};
      }
      shifted(3, v);
#pragma unroll
      for (int e = 0; e < 8; ++e) v[e] = 1.f - 2.f * __builtin_amdgcn_rcpf(1.f + __expf(2.f * v[e]));
      *(u32x4*)&twl[pti][cgp * 8] = pack8(v);
      shifted(4, v);
      *(u32x4*)&tal[pti][cgp * 8] = pack8(v);
    };
    auto prep2 = [&](int c) {
      const int buf = c & 1;
      bf16_t(*tA)[72] = pw < 2 ? twl : tal;
      f32x16 acc;
#pragma unroll
      for (int i = 0; i < 16; ++i) acc[i] = 0.f;
#pragma unroll
      for (int s = 0; s < 4; ++s) {
        bf16x8 a = *(const bf16x8*)&tA[r][16 * s + 8 * h];
        acc = MFMA32(a, bfr[s], acc);
      }
      const int col = (pw & 1) * 32 + r;
      if (pw < 2) {
#pragma unroll
        for (int i = 0; i < 16; ++i) {
          int tok = crow(i, h);
          float sg = sigmoidf_(c0 + acc[i]);
          sw[buf][tok][col] = __expf(-0.6065306597f * sg);
        }
      } else {
#pragma unroll
        for (int i = 0; i < 16; ++i) {
          int tok = crow(i, h);
          float a = sigmoidf_(c0 + acc[i]);
          float kv = stk[tok][col], kkv = skk[buf][tok][col];
          skd[buf][tok][col] = kv * (1.f + (a - 1.f) * c1);
          skka[buf][tok][col] = kkv * a;
        }
      }
    };
    auto scan_steps = [&](int c, int t0) {
      const int buf = c & 1;
      float ykeep = 0.f;
#pragma unroll
      for (int tt = 0; tt < 16; ++tt) {
        const int t = t0 + tt;
        f32x4 w4 = *(const f32x4*)&sw[buf][t][cgl * 4];
        f32x4 k4 = *(const f32x4*)&skk[buf][t][cgl * 4];
        f32x4 ka4 = *(const f32x4*)&skka[buf][t][cgl * 4];
        f32x4 kd4 = *(const f32x4*)&skd[buf][t][cgl * 4];
        f32x4 r4 = *(const f32x4*)&srr[buf][t][cgl * 4];
        float vv = svv[buf][t][rl];
        float dp = (S.x * k4.x + S.y * k4.y) + (S.z * k4.z + S.w * k4.w);
        dp = red16(dp);
        f32x4 u = kd4 * vv - ka4 * dp;
        S = S * w4 + u;
        float y = (S.x * r4.x + S.y * r4.y) + (S.z * r4.z + S.w * r4.w);
        y = red16(y);
        ykeep = (cgl == tt) ? y : ykeep;
      }
      syb[buf][t0 + cgl][rl] = ykeep;
    };
    auto flush = [&](int c) {
      const int buf = c & 1;
      int ti = tid >> 3, pr = tid & 7;
      int row = chunk_row(c, ti, d, b);
      unsigned o = pack2(syb[buf][ti][2 * pr], syb[buf][ti][2 * pr + 1]);
      *(unsigned*)(ydst + (size_t)row * yld + hh * 64 + rg * 16 + 2 * pr) = o;
    };

    __syncthreads();
    if (!is_scan) {
      issue(0);
      for (int i = ptid; i < 640; i += 256) {
        int g = i >> 7, pn = (i >> 6) & 1, cc = i & 63;
        int gb = g == 0 ? hh * 64 : g == 1 ? 1024 + hh * 64 : g == 2 ? 2048 + hh * 64 : g == 3 ? 3072 + d * 64 : 3200 + d * 64;
        smu[g][pn][cc] = (pn ? mun : mup)[gb + cc];
      }
    }
    __syncthreads();
    if (!is_scan) { prep1(0); issue(1); }
    __syncthreads();
    if (!is_scan) prep2(0);
    __syncthreads();
    for (int c = 0; c < NCH; ++c) {
      if (is_scan) { if (c > 0) flush(c - 1); scan_steps(c, 0); }
      else if (c + 1 < NCH) { prep1(c + 1); issue(min(c + 2, NCH - 1)); }
      __syncthreads();
      if (is_scan) scan_steps(c, 16);
      else if (c + 1 < NCH) prep2(c + 1);
      __syncthreads();
    }
    if (is_scan) flush(NCH - 1);
  }
}

DI void rwkv_readout_phase(const Params& P, int j) {
  const bf16_t* prw = (const bf16_t*)(P.ws + OFF_BIG);
  const bf16_t* ybw = (const bf16_t*)(P.ws + OFF_BIG + SZ_PRWKV);
  bf16_t* yab = (bf16_t*)(P.ws + OFF_YAB);
  const float* mup = P.mu_prev + j * 3328;
  const float* mun = P.mu_next + j * 3328;
  const int total = NR * 128;
  for (int task = blockIdx.x * NTHR + opaque_tid(); task < total; task += gridDim.x * NTHR) {
    int row = task >> 7, hc = task & 127;
    int col = hc * 8;
    int pos, seglen; row_seg(row, pos, seglen);
    bool hp = pos > 0, hn = pos < seglen - 1;
    float yf[8], yb[8], y[8];
    unpack8(*(const u32x4*)(yab + (size_t)row * 2048 + col), yf);
    unpack8(*(const u32x4*)(ybw + (size_t)row * 1024 + col), yb);
    float s = 0.f;
#pragma unroll
    for (int e = 0; e < 8; ++e) { y[e] = yf[e] + yb[e]; s += y[e]; }
    float mu = red8(s) * (1.f / 64.f);
    float q = 0.f;
#pragma unroll
    for (int e = 0; e < 8; ++e) { float dlt = y[e] - mu; q += dlt * dlt; }
    float rs = rsqrtf(red8(q) * (1.f / 64.f) + 64e-5f);
    float rr[8], kk[8], vv[8];
    load_shift8(prw, row, hp, hn, col, mup, mun, rr);
    load_shift8(prw, row, hp, hn, 1024 + col, mup, mun, kk);
    load_shift8(prw, row, hp, hn, 2048 + col, mup, mun, vv);
    float bsum = 0.f;
#pragma unroll
    for (int e = 0; e < 8; ++e) bsum += rr[e] * kk[e] * P.r_k[j * 1024 + col + e];
    bsum = red8(bsum);
    float o[8];
#pragma unroll
    for (int e = 0; e < 8; ++e)
      o[e] = (y[e] - mu) * rs * P.lnx_g[j * 1024 + col + e] + P.lnx_b[j * 1024 + col + e] + bsum * vv[e];
    *(u32x4*)(yab + (size_t)row * 2048 + col) = pack8(o);
  }
}

DI void hgrn_scan_phase(const Params& P, int j, char* smem) {
  typedef float (*arr128)[32][128];
  arr128 sq = (arr128)smem;
  arr128 sk = (arr128)(smem + 32768);
  float(*svv)[32][16] = (float(*)[32][16])(smem + 65536);
  float(*syb)[32][16] = (float(*)[32][16])(smem + 65536 + 4096);
  const int tid = opaque_tid(), wave = tid >> 6, lane = tid & 63;
  const bool is_scan = wave < 4;
  const bf16_t* hg = (const bf16_t*)(P.ws + OFF_BIG);
  constexpr int NCH = 264;
  for (int item = blockIdx.x; item < 256; item += gridDim.x) {
    const int vg = item & 7, d = (item >> 3) & 1, hh = (item >> 4) & 7, b = item >> 7;
    const int rl = (wave & 3) * 4 + ((lane >> 4) & 3), kg = lane & 15;
    const int ptid = tid - 256, pti = (ptid >> 3) & 31, cgp = ptid & 7;
    float S[8];
#pragma unroll
    for (int e = 0; e < 8; ++e) S[e] = 0.f;
    bf16_t* ydst = d == 0 ? (bf16_t*)(P.ws + OFF_YAB) + 1024 : (bf16_t*)(P.ws + OFF_BIG + SZ_HG);
    const int yld = d == 0 ? 2048 : 1024;

    u32x4 hraw[5];
    auto issue = [&](int c) {
      int row = chunk_row(c, pti, d, b);
      const bf16_t* hr = hg + (size_t)row * 4096;
      hraw[0] = *(const u32x4*)(hr + hh * 128 + cgp * 16);
      hraw[1] = *(const u32x4*)(hr + hh * 128 + cgp * 16 + 8);
      hraw[2] = *(const u32x4*)(hr + 1024 * (1 + d) + hh * 128 + cgp * 16);
      hraw[3] = *(const u32x4*)(hr + 1024 * (1 + d) + hh * 128 + cgp * 16 + 8);
      hraw[4] = *(const u32x4*)(hr + 3072 + hh * 128 + vg * 16 + (cgp & 1) * 8);
    };
    auto prep = [&](int c) {
      const int buf = c & 1;
      float v[8];
#pragma unroll
      for (int half = 0; half < 2; ++half) {
        int cc = cgp * 16 + half * 8;
        unpack8(hraw[half], v);
        *(f32x4*)&sq[buf][pti][cc] = (f32x4){v[0], v[1], v[2], v[3]};
        *(f32x4*)&sq[buf][pti][cc + 4] = (f32x4){v[4], v[5], v[6], v[7]};
        unpack8(hraw[2 + half], v);
        *(f32x4*)&sk[buf][pti][cc] = (f32x4){v[0], v[1], v[2], v[3]};
        *(f32x4*)&sk[buf][pti][cc + 4] = (f32x4){v[4], v[5], v[6], v[7]};
      }
      if (cgp < 2) {
        unpack8(hraw[4], v);
        *(f32x4*)&svv[buf][pti][cgp * 8] = (f32x4){v[0], v[1], v[2], v[3]};
        *(f32x4*)&svv[buf][pti][cgp * 8 + 4] = (f32x4){v[4], v[5], v[6], v[7]};
      }
    };
    auto scan_steps = [&](int c) {
      const int buf = c & 1;
#pragma unroll 1
      for (int t0 = 0; t0 < 32; t0 += 16) {
        float ykeep = 0.f;
#pragma unroll
        for (int tt = 0; tt < 16; ++tt) {
          const int t = t0 + tt;
          f32x4 k0 = *(const f32x4*)&sk[buf][t][kg * 8], k1 = *(const f32x4*)&sk[buf][t][kg * 8 + 4];
          f32x4 q0 = *(const f32x4*)&sq[buf][t][kg * 8], q1 = *(const f32x4*)&sq[buf][t][kg * 8 + 4];
          float vv = svv[buf][t][rl];
          float kk[8] = {k0.x, k0.y, k0.z, k0.w, k1.x, k1.y, k1.z, k1.w};
          float qq[8] = {q0.x, q0.y, q0.z, q0.w, q1.x, q1.y, q1.z, q1.w};
          float o = 0.f;
#pragma unroll
          for (int e = 0; e < 8; ++e) {
            S[e] = (1.f - kk[e]) * S[e] + kk[e] * vv;
            o += S[e] * qq[e];
          }
          o = red16(o);
          ykeep = (kg == tt) ? o : ykeep;
        }
        syb[buf][t0 + kg][rl] = ykeep;
      }
    };
    auto flush = [&](int c) {
      const int buf = c & 1;
      int ti = tid >> 3, pr = tid & 7;
      int row = chunk_row(c, ti, d, b);
      unsigned o = pack2(syb[buf][ti][2 * pr], syb[buf][ti][2 * pr + 1]);
      *(unsigned*)(ydst + (size_t)row * yld + hh * 128 + vg * 16 + 2 * pr) = o;
    };
    __syncthreads();
    if (!is_scan) { issue(0); prep(0); issue(1); }
    __syncthreads();
    for (int c = 0; c < NCH; ++c) {
      if (is_scan) { if (c > 0) flush(c - 1); scan_steps(c); }
      else if (c + 1 < NCH) { prep(c + 1); issue(min(c + 2, NCH - 1)); }
      __syncthreads();
    }
    if (is_scan) flush(NCH - 1);
  }
}

DI void hgrn_readout_phase(const Params& P, int j) {
  const bf16_t* obw = (const bf16_t*)(P.ws + OFF_BIG + SZ_HG);
  bf16_t* yab = (bf16_t*)(P.ws + OFF_YAB);
  const int total = NR * 128;
  for (int task = blockIdx.x * NTHR + opaque_tid(); task < total; task += gridDim.x * NTHR) {
    int row = task >> 7, hc = task & 127;
    int col = hc * 8;
    float of[8], ob[8], o[8];
    unpack8(*(const u32x4*)(yab + (size_t)row * 2048 + 1024 + col), of);
    unpack8(*(const u32x4*)(obw + (size_t)row * 1024 + col), ob);
    float q = 0.f;
#pragma unroll
    for (int e = 0; e < 8; ++e) { o[e] = of[e] + ob[e]; q += o[e] * o[e]; }
    float rs = rsqrtf(red16(q) * (1.f / 128.f) + 1e-5f);
#pragma unroll
    for (int e = 0; e < 8; ++e) o[e] = o[e] * rs * P.hnorm_g[j * 128 + ((col + e) & 127)];
    *(u32x4*)(yab + (size_t)row * 2048 + 1024 + col) = pack8(o);
  }
}

DI void attn_phase(const Params& P, int j, bool need_ctx, char* smem, bool dry) {
  bf16_t(*sK)[64][72] = (bf16_t(*)[64][72])smem;
  bf16_t(*sV)[128][72] = (bf16_t(*)[128][72])(smem + 2 * 64 * 72 * 2);
  unsigned(*sO)[NTHR] = (unsigned(*)[NTHR])(smem + 2 * 64 * 72 * 2 + 2 * 128 * 72 * 2);
  const int tid = opaque_tid(), wave = tid >> 6, lane = tid & 63, r = lane & 31, h = lane >> 5;
  bf16_t* qbuf = (bf16_t*)(P.ws + OFF_YAB);
  const bf16_t* kbuf = (const bf16_t*)(P.ws + OFF_BIG);
  const bf16_t* vtb = (const bf16_t*)(P.ws + OFF_BIG + SZ_N2048);
  const float lam = ((const float*)(P.ws + OFF_LAM))[j];
  const float lam_init = P.lam_init[j];
  const float CS = 0.125f * 1.4426950408889634f;
  const int nitems = 1024 + (need_ctx ? 32 : 0);
  for (int item = blockIdx.x; item < nitems; item += gridDim.x) {
    int b, head, qrow0, ntiles;
    if (item < 1024) {
      int round = item >> 8, slot = item & 255, xcd = slot & 7, qb = slot >> 3;
      int bh = round * 8 + xcd;
      b = bh >> 4; head = bh & 15; qrow0 = b * 8192 + qb * 256; ntiles = 132;
    } else {
      int it = item - 1024; head = it & 15; b = it >> 4; qrow0 = NLAT + b * 256; ntiles = 4;
    }
    const int qrow = qrow0 + wave * 32 + r;
    const bf16_t* vbase = vtb + (size_t)(b * 16 + head) * 128 * 8448;
#pragma unroll 1
    for (int m = 0; m < 2; ++m) {
      bf16x8 qf[4];
#pragma unroll
      for (int s = 0; s < 4; ++s) qf[s] = *(const bf16x8*)(qbuf + (size_t)qrow * 2048 + head * 128 + m * 64 + 16 * s + 8 * h);
      f32x16 oacc[4];
#pragma unroll
      for (int vt = 0; vt < 4; ++vt)
#pragma unroll
        for (int i = 0; i < 16; ++i) oacc[vt][i] = 0.f;
      float mrun = -1e30f, lsum = 0.f;
      const int kcol = head * 128 + m * 64 + (tid & 7) * 8;
      auto kaddr = [&](int tile) -> const bf16_t* {
        int kidx = tile * 64 + (tid >> 3);
        int krow = kidx < 256 ? (NLAT + b * 256 + kidx) : (b * 8192 + kidx - 256);
        return kbuf + (size_t)krow * 2048 + kcol;
      };
      const bf16_t* vp = vbase + (size_t)(tid >> 3) * 8448 + (tid & 7) * 8;
      const int srow = tid >> 3, scol = (tid & 7) * 8;
      __syncthreads();
      {
        u32x4 k0 = *(const u32x4*)kaddr(0), k1 = *(const u32x4*)kaddr(1);
        u32x4 v0 = *(const u32x4*)(vp), v1 = *(const u32x4*)(vp + (size_t)64 * 8448);
        *(u32x4*)&sK[0][srow][scol] = k0;
        *(u32x4*)&sK[1][srow][scol] = k1;
        *(u32x4*)&sV[0][srow][scol] = v0;
        *(u32x4*)&sV[0][64 + srow][scol] = v1;
      }
      __syncthreads();
      f32x16 sA_[2], sB_[2];
      auto qk = [&](f32x16* sacc, int buf) {
#pragma unroll
        for (int kt = 0; kt < 2; ++kt)
#pragma unroll
          for (int i = 0; i < 16; ++i) sacc[kt][i] = 0.f;
#pragma unroll
        for (int s = 0; s < 4; ++s)
#pragma unroll
          for (int kt = 0; kt < 2; ++kt) {
            bf16x8 a = *(const bf16x8*)&sK[buf][kt * 32 + r][16 * s + 8 * h];
            sacc[kt] = MFMA32(a, qf[s], sacc[kt]);
          }
      };
      auto step = [&](f32x16* cur, f32x16* nxt, int tile) {
        const int buf = tile & 1;
        const int tk = min(tile + 2, ntiles - 1), tv = min(tile + 1, ntiles - 1);
        u32x4 rk = *(const u32x4*)kaddr(tk);
        u32x4 rv0 = *(const u32x4*)(vp + tv * 64);
        u32x4 rv1 = *(const u32x4*)(vp + (size_t)64 * 8448 + tv * 64);
        qk(nxt, buf ^ 1);
        float mx = cur[0][0];
#pragma unroll
        for (int kt = 0; kt < 2; ++kt)
#pragma unroll
          for (int i = 0; i < 16; ++i) mx = fmaxf(mx, cur[kt][i]);
        mx = fmaxf(mx, __shfl_xor(mx, 32));
        float mnew = fmaxf(mrun, mx);
        float alpha = __builtin_amdgcn_exp2f((mrun - mnew) * CS);
        if (__any(alpha != 1.f)) {
          lsum *= alpha;
#pragma unroll
          for (int vt = 0; vt < 4; ++vt)
#pragma unroll
            for (int i = 0; i < 16; ++i) oacc[vt][i] *= alpha;
        }
        mrun = mnew;
        const float mb = mnew * CS;
        bf16x8 pb[2][2];
#pragma unroll
        for (int kt = 0; kt < 2; ++kt)
#pragma unroll
          for (int s2 = 0; s2 < 2; ++s2) {
            float pv[8];
#pragma unroll
            for (int e = 0; e < 8; ++e) { pv[e] = __builtin_amdgcn_exp2f(cur[kt][8 * s2 + e] * CS - mb); lsum += pv[e]; }
            u32x4 pk = pack8(pv);
            pb[kt][s2] = __builtin_bit_cast(bf16x8, pk);
          }
#pragma unroll
        for (int kt = 0; kt < 2; ++kt)
#pragma unroll
          for (int s2 = 0; s2 < 2; ++s2)
#pragma unroll
            for (int vt = 0; vt < 4; ++vt) {
              const bf16_t* vrow = &sV[buf][vt * 32 + r][kt * 32 + 16 * s2 + 4 * h];
              s16x4 lo = *(const s16x4*)vrow;
              s16x4 hi = *(const s16x4*)(vrow + 8);
              bf16x8 a = __builtin_shufflevector(lo, hi, 0, 1, 2, 3, 4, 5, 6, 7);
              oacc[vt] = MFMA32(a, pb[kt][s2], oacc[vt]);
            }
        *(u32x4*)&sK[buf][srow][scol] = rk;
        *(u32x4*)&sV[buf ^ 1][srow][scol] = rv0;
        *(u32x4*)&sV[buf ^ 1][64 + srow][scol] = rv1;
        __syncthreads();
      };
      qk(sA_, 0);
      for (int tile = 0; tile < ntiles; tile += 2) {
        step(sA_, sB_, tile);
        step(sB_, sA_, tile + 1);
      }
      float ltot = lsum + __shfl_xor(lsum, 32);
      float inv = 1.f / ltot;
      if (m == 0) {
#pragma unroll
        for (int vt = 0; vt < 4; ++vt)
#pragma unroll
          for (int i = 0; i < 8; ++i) sO[vt * 8 + i][tid] = pack2(oacc[vt][2 * i] * inv, oacc[vt][2 * i + 1] * inv);
      } else {
        float ss = 0.f;
#pragma unroll
        for (int vt = 0; vt < 4; ++vt)
#pragma unroll
          for (int i = 0; i < 8; ++i) {
            unsigned u = sO[vt * 8 + i][tid];
            float o0 = bflo(u) - lam * oacc[vt][2 * i] * inv, o1 = bfhi(u) - lam * oacc[vt][2 * i + 1] * inv;
            oacc[vt][2 * i] = o0; oacc[vt][2 * i + 1] = o1; ss += o0 * o0 + o1 * o1;
          }
        ss += __shfl_xor(ss, 32);
        float rs = rsqrtf(ss * (1.f / 128.f) + 1e-5f) * (1.f - lam_init);
#pragma unroll
        for (int vt = 0; vt < 4; ++vt)
#pragma unroll
          for (int g4 = 0; g4 < 4; ++g4) {
            int v0 = vt * 32 + 8 * g4 + 4 * h;
            float4 gg = *(const float4*)(P.subln_g + j * 128 + v0);
            u32x2 o;
            o.x = pack2(oacc[vt][4 * g4 + 0] * rs * gg.x, oacc[vt][4 * g4 + 1] * rs * gg.y);
            o.y = pack2(oacc[vt][4 * g4 + 2] * rs * gg.z, oacc[vt][4 * g4 + 3] * rs * gg.w);
            if (!dry) *(u32x2*)(qbuf + (size_t)qrow * 2048 + head * 128 + v0) = o;
          }
      }
    }
  }
}

DI void run_phase(const Params& P, int ph, char* smem, bool dry) {
  const bf16_t* wt = (const bf16_t*)(P.ws + OFF_WT);
  const bf16_t* hb = (const bf16_t*)(P.ws + OFF_HB);
  const bf16_t* yab = (const bf16_t*)(P.ws + OFF_YAB);
  if (ph == 0) { prologue_phase(P, smem); return; }
  if (ph == 1) { ln_phase(P, 0, false, true, 0); return; }
  int q = ph - 2;
  int layer, sub;
  if (q < 9) { layer = 0; sub = q; }
  else if (q < 14) { layer = 1; sub = q - 9; }
  else if (q < 23) { layer = 2; sub = q - 14; }
  else { layer = 3; sub = q - 23; }
  const int j = layer >> 1;
  if ((layer & 1) == 0) {
    switch (sub) {
      case 0: gemm_phase<EPI_R>(P, hb, 1024, wt, 13, 1024, layer, smem); break;
      case 1: rwkv_scan_phase(P, j, smem); break;
      case 2: rwkv_readout_phase(P, j); break;
      case 3: gemm_phase<EPI_H>(P, hb, 1024, wt + (size_t)3328 * 1024, 16, 1024, layer, smem); break;
      case 4: hgrn_scan_phase(P, j, smem); break;
      case 5: hgrn_readout_phase(P, j); break;
      case 6: gemm_phase<EPI_G>(P, hb, 1024, wt + (size_t)7424 * 1024, 8, 1024, layer, smem); break;
      case 7: gemm_phase<EPI_O>(P, yab, 2048, wt + (size_t)9472 * 1024, 4, 2048, layer, smem); break;
      default:
        ln_phase(P, layer, true, true, layer + 1);
        convert_layer_weights(P, layer + 1, smem);
        break;
    }
  } else {
    switch (sub) {
      case 0:
        gemm_phase<EPI_QK>(P, hb, 1024, wt, 16, 1024, layer, smem);
        gemm_phase<EPI_V>(P, hb, 1024, wt + (size_t)4096 * 1024, 8, 1024, layer, smem);
        break;
      case 1: attn_phase(P, j, layer < 3, smem, dry); break;
      case 2: gemm_phase<EPI_G>(P, hb, 1024, wt + (size_t)6144 * 1024, 8, 1024, layer, smem, layer < 3 ? 66 : 64); break;
      case 3: gemm_phase<EPI_O>(P, yab, 2048, wt + (size_t)8192 * 1024, 4, 2048, layer, smem, layer < 3 ? 66 : 64); break;
      default:
        ln_phase(P, layer, true, layer < 3, layer + 1);
        if (layer < 3) convert_layer_weights(P, layer + 1, smem);
        break;
    }
  }
}
constexpr int NPHASES = 30;

__global__ void __launch_bounds__(NTHR) mega_kernel(Params P, int lo, int hi) {
  __shared__ __attribute__((aligned(16))) char smem[147456];
  cg::grid_group grid = cg::this_grid();
  for (int ph = lo; ph < hi; ++ph) {
    int reps = 1;
#ifdef PROBE_DUP_SCAN
    if (ph == 3 || ph == 6 || ph == 17 || ph == 20) reps = 2;
#endif
#ifdef PROBE_DUP_ATTN
    if (ph == 12 || ph == 26) reps = 2;
#endif
#ifdef PROBE_DUP_GEMM_IN
    if (ph == 2 || ph == 5 || ph == 11 || ph == 16 || ph == 19 || ph == 25) reps = 2;
#endif
    for (int rep = 0; rep < reps; ++rep) {
      run_phase(P, ph, smem, rep + 1 < reps);
      if (rep + 1 < reps) grid.sync();
    }
    if (ph + 1 < hi) grid.sync();
  }
}

extern "C" void kernel_launch(void* const* d_in, const int* in_sizes, int n_in, void* d_out, int out_size,
                              void* d_ws, size_t ws_size, hipStream_t stream) {
  if (ws_size < WS_NEEDED) { fprintf(stderr, "workspace too small: %zu < %zu\n", ws_size, WS_NEEDED); return; }
  Params p{};
  const float** pp = (const float**)&p;
  for (int i = 0; i < 27; ++i) pp[i] = (const float*)d_in[i];
  p.out = (float*)d_out;
  p.ws = (char*)d_ws;
  p.lam_init[0] = (float)(0.8 - 0.6 * exp(-0.3 * 1.0));
  p.lam_init[1] = (float)(0.8 - 0.6 * exp(-0.3 * 3.0));
  static int grid_blocks = 0;
  if (!grid_blocks) {
    int dev = 0, cus = 0, per_cu = 0;
    hipGetDevice(&dev);
    hipDeviceGetAttribute(&cus, hipDeviceAttributeMultiprocessorCount, dev);
    hipOccupancyMaxActiveBlocksPerMultiprocessor(&per_cu, mega_kernel, NTHR, 0);
    if (per_cu < 1) per_cu = 1;
    grid_blocks = cus * per_cu;
  }
  int lo = 0, hi = NPHASES;
  void* args[] = {&p, &lo, &hi};
  hipError_t e = hipLaunchCooperativeKernel((void*)mega_kernel, dim3(grid_blocks), dim3(NTHR), args, 0, stream);
  if (e != hipSuccess) fprintf(stderr, "cooperative launch failed: %s (grid %d)\n", hipGetErrorString(e), grid_blocks);
}
```
